# Optimizing an MI355X kernel written in HIP

```python
import math
import jax, jax.numpy as jnp
from jax import lax
import numpy as np

D_MODEL = 1024
BATCH = 8
SEQ = 4096
DEPTH = 4

CHUNK = 64
D_SSM = D_MODEL // 2
SSM_GROUP = 16
N_SSM_GROUPS = D_SSM // SSM_GROUP
SSM_STATE = 64
D_SGU = D_MODEL - D_SSM
SGU_HEADS = 8
SGU_HEAD_DIM = D_SGU // SGU_HEADS
SGU_BLOCK = 128
D_IN = D_SSM + 2 * D_SGU
D_FF = -(-8 * D_MODEL // (3 * 256)) * 256
PLE_DIM = 256
ALPHA = (2 * DEPTH) ** 0.25
BETA = (8 * DEPTH) ** -0.25
LN_EPS = 1e-5
DT_MIN, DT_MAX = 1e-3, 1e-1

kernel_name = "hybrid_s5_sgu_deepnorm_encoder"


def layer_norm(x, g, b):
    xf = x.astype(jnp.float32)
    mu = jnp.mean(xf, -1, keepdims=True)
    var = jnp.mean(jnp.square(xf - mu), -1, keepdims=True)
    return ((xf - mu) * lax.rsqrt(var + LN_EPS) * g.astype(jnp.float32)
            + b.astype(jnp.float32)).astype(x.dtype)


def rms_norm(x, g):
    xf = x.astype(jnp.float32)
    return (xf * lax.rsqrt(jnp.mean(xf * xf, -1, keepdims=True) + LN_EPS)
            * g.astype(jnp.float32)).astype(x.dtype)


def s5_mixer(u, a_re, a_im, log_dt, b_re, b_im, c_re, c_im, d_skip, w_glu):
    bsz, seq, _ = u.shape
    f32 = jnp.float32
    ug = u.astype(f32).reshape(bsz, seq, N_SSM_GROUPS, SSM_GROUP)
    lam = lax.complex(a_re.astype(f32), a_im.astype(f32))
    dt = jnp.exp(log_dt.astype(f32))[:, None]
    a_bar = jnp.exp(lam * dt)
    b_cplx = lax.complex(b_re.astype(f32), b_im.astype(f32))
    b_bar = ((a_bar - 1.0) / lam)[..., None] * b_cplx
    bu = jnp.einsum('gph,blgh->blgp', b_bar, ug.astype(jnp.complex64))
    a_seq = jnp.broadcast_to(a_bar[None, None], (1, seq) + a_bar.shape)

    def combine(left, right):
        a_l, b_l = left
        a_r, b_r = right
        return a_l * a_r, a_r * b_l + b_r

    _, states = lax.associative_scan(combine, (a_seq, bu), axis=1)
    c_cplx = lax.complex(c_re.astype(f32), c_im.astype(f32))
    y = jnp.einsum('ghp,blgp->blgh', c_cplx, states).real + d_skip.astype(f32) * ug
    y = jax.nn.gelu(y.reshape(bsz, seq, D_SSM))
    y = y * jax.nn.sigmoid(y @ w_glu.astype(f32))
    return y.astype(u.dtype)


def sgu_mixer(z, ln_g, ln_b, w_s, b_s):
    z = jax.nn.gelu(z)
    u, v = z[..., :D_SGU], z[..., D_SGU:]
    v = layer_norm(v, ln_g, ln_b)
    bsz, seq, _ = v.shape
    n_blk = seq // SGU_BLOCK
    vb = v.reshape(bsz, n_blk, SGU_BLOCK, SGU_HEADS, SGU_HEAD_DIM)
    chunk_id = jnp.arange(SGU_BLOCK) // CHUNK
    mask = chunk_id[:, None] >= chunk_id[None, :]
    w = jnp.where(mask[None], w_s, jnp.zeros_like(w_s))
    s = jnp.einsum('hij,bnjhc->bnihc', w, vb) + b_s.T[None, None, :, :, None]
    return u * s.reshape(bsz, seq, D_SGU)


def setup_inputs(seed: int = 0) -> dict:
    key = jax.random.key(seed)
    ks = iter(jax.random.split(key, 40))

    def nrm(shape, scale):
        return scale * jax.random.normal(next(ks), shape, jnp.float32)

    n_idx = jnp.arange(SSM_STATE, dtype=jnp.float32)
    G, P, H = N_SSM_GROUPS, SSM_STATE, SSM_GROUP
    inp = {}
    inp["x"] = nrm((BATCH, SEQ, D_MODEL), 1.0)
    inp["p"] = nrm((DEPTH, BATCH, SEQ, PLE_DIM), 1.0)
    inp["emb_ln_g"] = 1.0 + nrm((D_MODEL,), 0.02)
    inp["emb_ln_b"] = nrm((D_MODEL,), 0.02)
    inp["w_in"] = nrm((DEPTH, D_MODEL, D_IN), D_MODEL ** -0.5)
    inp["ssm_a_re"] = -0.5 + nrm((DEPTH, G, P), 0.01)
    inp["ssm_a_im"] = math.pi * n_idx + nrm((DEPTH, G, P), 0.01)
    inp["ssm_log_dt"] = jax.random.uniform(next(ks), (DEPTH, G), jnp.float32,
                                           math.log(DT_MIN), math.log(DT_MAX))
    inp["ssm_b_re"] = nrm((DEPTH, G, P, H), (2 * H) ** -0.5)
    inp["ssm_b_im"] = nrm((DEPTH, G, P, H), (2 * H) ** -0.5)
    inp["ssm_c_re"] = nrm((DEPTH, G, H, P), (2 * P) ** -0.5)
    inp["ssm_c_im"] = nrm((DEPTH, G, H, P), (2 * P) ** -0.5)
    inp["ssm_d"] = nrm((DEPTH, G, H), 1.0)
    inp["ssm_w_glu"] = nrm((DEPTH, D_SSM, D_SSM), D_SSM ** -0.5)
    inp["sgu_ln_g"] = 1.0 + nrm((DEPTH, D_SGU), 0.02)
    inp["sgu_ln_b"] = nrm((DEPTH, D_SGU), 0.02)
    inp["sgu_w_s"] = nrm((DEPTH, SGU_HEADS, SGU_BLOCK, SGU_BLOCK), SGU_BLOCK ** -0.5)
    inp["sgu_b_s"] = 1.0 + nrm((DEPTH, SGU_HEADS, SGU_BLOCK), 0.1)
    inp["out_g_ssm"] = 1.0 + nrm((DEPTH, D_SSM), 0.02)
    inp["out_g_sgu"] = 1.0 + nrm((DEPTH, D_SGU), 0.02)
    inp["w_out"] = nrm((DEPTH, D_MODEL, D_MODEL), BETA * D_MODEL ** -0.5)
    inp["ln1_g"] = 1.0 + nrm((DEPTH, D_MODEL), 0.02)
    inp["ln1_b"] = nrm((DEPTH, D_MODEL), 0.02)
    inp["w_ffn_gate"] = nrm((DEPTH, D_MODEL, D_FF), D_MODEL ** -0.5)
    inp["w_ffn_up"] = nrm((DEPTH, D_MODEL, D_FF), D_MODEL ** -0.5)
    inp["w_ffn_down"] = nrm((DEPTH, D_FF, D_MODEL), BETA * D_FF ** -0.5)
    inp["w_ple"] = nrm((DEPTH, PLE_DIM, D_MODEL), BETA * PLE_DIM ** -0.5)
    inp["w_ple_gate"] = nrm((DEPTH, D_MODEL, D_MODEL), D_MODEL ** -0.5)
    inp["b_ple_gate"] = nrm((DEPTH, D_MODEL), 0.02)
    inp["ln2_g"] = 1.0 + nrm((DEPTH, D_MODEL), 0.02)
    inp["ln2_b"] = nrm((DEPTH, D_MODEL), 0.02)
    return inp


def reference(x, p, emb_ln_g, emb_ln_b, w_in, ssm_a_re, ssm_a_im, ssm_log_dt,
              ssm_b_re, ssm_b_im, ssm_c_re, ssm_c_im, ssm_d, ssm_w_glu,
              sgu_ln_g, sgu_ln_b, sgu_w_s, sgu_b_s, out_g_ssm, out_g_sgu, w_out,
              ln1_g, ln1_b, w_ffn_gate, w_ffn_up, w_ffn_down, w_ple, w_ple_gate,
              b_ple_gate, ln2_g, ln2_b):
    h = layer_norm(x, emb_ln_g, emb_ln_b)
    for i in range(DEPTH):
        z = h @ w_in[i]
        y_ssm = s5_mixer(z[..., :D_SSM], ssm_a_re[i], ssm_a_im[i], ssm_log_dt[i],
                         ssm_b_re[i], ssm_b_im[i], ssm_c_re[i], ssm_c_im[i],
                         ssm_d[i], ssm_w_glu[i])
        y_sgu = sgu_mixer(z[..., D_SSM:], sgu_ln_g[i], sgu_ln_b[i], sgu_w_s[i], sgu_b_s[i])
        mix = jnp.concatenate([rms_norm(y_ssm, out_g_ssm[i]),
                               rms_norm(y_sgu, out_g_sgu[i])], axis=-1) @ w_out[i]
        h = layer_norm(ALPHA * h + mix, ln1_g[i], ln1_b[i])
        ffn = (jax.nn.silu(h @ w_ffn_gate[i]) * (h @ w_ffn_up[i])) @ w_ffn_down[i]
        ple = (p[i] @ w_ple[i]) * jax.nn.sigmoid(h @ w_ple_gate[i] + b_ple_gate[i])
        h = layer_norm(ALPHA * h + ffn + ple, ln2_g[i], ln2_b[i])
    return h
```

```cpp
#include <hip/hip_runtime.h>
#include <hip/hip_cooperative_groups.h>
#include <cstdio>
#include <cstdint>
namespace cg = cooperative_groups;


#ifndef DOUBLE_MASK
#define DOUBLE_MASK 0
#endif
#ifndef MK_SPLIT
#define MK_SPLIT 0
#endif

namespace pg8 {
#define PG8_LAS __attribute__((address_space(3)))
typedef unsigned short bf16_t;
typedef short bf16x8 __attribute__((ext_vector_type(8)));
typedef float f32x4 __attribute__((ext_vector_type(4)));
typedef unsigned u32x4 __attribute__((ext_vector_type(4)));
typedef unsigned u32x2 __attribute__((ext_vector_type(2)));
constexpr int BM = 256, BK = 64, HALF = 128, HTB = HALF * BK * 2, STAGE_BYTES = 8 * HTB, NXCD = 8, WGM = 4;

__host__ __device__ __forceinline__ int lds_byte(int r, int c) { const int st = (r >> 4) * 2 + (c >> 5), rr = r & 15, cc = c & 31, ob = rr * 64 + cc * 2; return st * 1024 + (ob ^ (((ob >> 9) & 1) << 5)); }
__host__ __device__ __forceinline__ void stage_rc(int b, int& R, int& C) { const int st = b / 1024, sb = b % 1024, swz = sb ^ (((sb >> 9) & 1) << 5); R = (st >> 1) * 16 + swz / 64; C = (st & 1) * 32 + (swz % 64) / 2; }
__host__ __device__ __forceinline__ int perm32(int rho) { const int n = rho >> 4, i = rho & 15; return 8 * (i >> 2) + 4 * n + (i & 3); }

struct Unit { int pm, pn; };
struct Gemm { const bf16_t* A; const bf16_t* Bt; int M, N, K, lda, ldb; };

struct StaticOrder {
    int nM, nN, nwg, G, c;
    __host__ __device__ void init(int M, int N, int G_, int c_) { nM = M / BM; nN = N / BM; nwg = nM * nN; G = G_; c = c_; }
    __host__ __device__ bool next(int i, Unit& u) const {
        const long L = (long)i * G + c; if (L >= nwg) return false;
        int wgid = (int)L; { const int q = nwg / NXCD, r = nwg % NXCD, xcd = wgid % NXCD, off = wgid / NXCD; wgid = (xcd < r ? xcd * (q + 1) : r * (q + 1) + (xcd - r) * q) + off; }
        const int nig = WGM * nN, gid = wgid / nig, fm = gid * WGM, gsz = (nM - fm) < WGM ? (nM - fm) : WGM;
        u.pm = fm + ((wgid % nig) % gsz); u.pn = (wgid % nig) / gsz; return true;
    }
};
struct OneUnit { Unit u; __device__ bool next(int i, Unit& o) const { if (i) return false; o = u; return true; } };

typedef float f32x2_t __attribute__((ext_vector_type(2)));
typedef __bf16 bf16x2_t __attribute__((ext_vector_type(2)));
__device__ __forceinline__ unsigned cvt_pk_bf16(float lo, float hi) { f32x2_t v = {lo, hi}; bf16x2_t b = __builtin_convertvector(v, bf16x2_t); return __builtin_bit_cast(unsigned, b); }

template <class Epi, class Sched>
__device__ __forceinline__ void gemm_phase(PG8_LAS unsigned char* lds, const Gemm g, const Sched& S, const Epi& E) {
    int tid_ = threadIdx.x; asm volatile("" : "+v"(tid_));
    const int tid = tid_, wid = __builtin_amdgcn_readfirstlane(tid >> 6), lane = tid & 63, wr = wid >> 2, wc = wid & 3, fr = lane & 15, fq = lane >> 4;
    const int K = g.K, nt = K / BK;
    unsigned voffA[2], voffB[2];
#pragma unroll
    for (int i = 0; i < 2; ++i) { int R, C; stage_rc(tid * 16 + i * 8192, R, C); const int Rb = Epi::PERM ? ((R & ~31) + perm32(R & 31)) : R;
        voffA[i] = (unsigned)(R * g.lda + C) * 2u; voffB[i] = (unsigned)(Rb * g.ldb + C) * 2u; }
    const size_t kstep = (size_t)(BK * 2);
    const size_t hA = (size_t)HALF * g.lda * 2, hB = (size_t)HALF * g.ldb * 2;
    const size_t tA = 2 * hA, tB = 2 * hB;
    const unsigned ldsw = (unsigned)wid * 1024u;
    const int aoff = lds_byte(wr * 64 + fr, fq * 8), boff = lds_byte(wc * 32 + fr, fq * 8);
#define PG8_SA(b, h) (((b) * 2 + (h)) * HTB)
#define PG8_SB(b, h) ((4 + (b) * 2 + (h)) * HTB)
#define PG8_STAGE(bufoff, gbase, voff) do { _Pragma("unroll") for (int _i = 0; _i < 2; ++_i) \
        __builtin_amdgcn_global_load_lds((const unsigned*)((const char*)(gbase) + (voff)[_i]), (PG8_LAS unsigned*)(lds + (bufoff) + ldsw + _i * 8192), 16, 0, 0); } while (0)
#define PG8_LDA(dst, b, h) do { _Pragma("unroll") for (int m = 0; m < 4; ++m) _Pragma("unroll") for (int k = 0; k < 2; ++k) dst[m][k] = *(const PG8_LAS bf16x8*)(lds + PG8_SA(b, h) + aoff + m * 2048 + k * 1024); } while (0)
#define PG8_LDB(dst, b, h) do { _Pragma("unroll") for (int n = 0; n < 2; ++n) _Pragma("unroll") for (int k = 0; k < 2; ++k) dst[n][k] = *(const PG8_LAS bf16x8*)(lds + PG8_SB(b, h) + boff + n * 2048 + k * 1024); } while (0)
#define PG8_MMA(ai, bj, At, Bt) do { __builtin_amdgcn_s_setprio(1); _Pragma("unroll") for (int m = 0; m < 4; ++m) _Pragma("unroll") for (int n = 0; n < 2; ++n) _Pragma("unroll") for (int k = 0; k < 2; ++k) \
        acc[ai][bj][m][n] = __builtin_amdgcn_mfma_f32_16x16x32_bf16(Bt[n][k], At[m][k], acc[ai][bj][m][n], 0, 0, 0); __builtin_amdgcn_s_setprio(0); } while (0)
#define PG8_WAIT_V(n) asm volatile("s_waitcnt vmcnt(" #n ")" ::: "memory")
#define PG8_WAIT_L(n) asm volatile("s_waitcnt lgkmcnt(" #n ")" ::: "memory")
#define PG8_BAR __builtin_amdgcn_s_barrier()
#define PG8_SCHED __builtin_amdgcn_sched_barrier(0)
    Unit cur, nxt; int ui = 0;
    if (!S.next(0, cur)) return;
    f32x4 acc[2][2][4][2];
#pragma unroll
    for (int a = 0; a < 2; ++a)
#pragma unroll
        for (int b = 0; b < 2; ++b)
#pragma unroll
            for (int m = 0; m < 4; ++m)
#pragma unroll
                for (int n = 0; n < 2; ++n) acc[a][b][m][n] = (f32x4){0.f, 0.f, 0.f, 0.f};
    bf16x8 At[4][2], B0[2][2], B1[2][2];
    const char* cA = (const char*)g.A + (size_t)cur.pm * tA; const char* cB = (const char*)g.Bt + (size_t)cur.pn * tB;
    PG8_STAGE(PG8_SB(0, 0), cB, voffB); PG8_STAGE(PG8_SB(0, 1), cB + hB, voffB); PG8_STAGE(PG8_SA(0, 0), cA, voffA); PG8_STAGE(PG8_SA(0, 1), cA + hA, voffA);
    if (wr == 1) PG8_BAR;
    PG8_WAIT_V(2); PG8_BAR;
    PG8_STAGE(PG8_SB(1, 0), cB + kstep, voffB); PG8_STAGE(PG8_SA(1, 0), cA + kstep, voffA); PG8_STAGE(PG8_SB(1, 1), cB + hB + kstep, voffB);
    PG8_WAIT_V(6); PG8_BAR;
    for (;;) {
        const bool has_next = S.next(ui + 1, nxt);
        const char* nA = has_next ? (const char*)g.A + (size_t)nxt.pm * tA : cA; const char* nB = has_next ? (const char*)g.Bt + (size_t)nxt.pn * tB : cB;
#pragma unroll 1
        for (int t = 0; t < nt; t += 2) {
            if constexpr (Epi::MID_T >= 0) { if (t == Epi::MID_T) E.mid(acc, cur, wr, wc, fr, fq); }
            const bool last = (t == nt - 2);
            const char* a1 = cA + (size_t)(t + 1) * kstep;
            const char* a2 = last ? nA : cA + (size_t)(t + 2) * kstep; const char* b2 = last ? nB : cB + (size_t)(t + 2) * kstep;
            const char* a3 = a2 + kstep; const char* b3 = b2 + kstep;
            PG8_LDB(B0, 0, 0); PG8_LDB(B1, 0, 1); PG8_SCHED; PG8_LDA(At, 0, 0); PG8_STAGE(PG8_SA(1, 1), a1 + hA, voffA);
            PG8_WAIT_V(8); PG8_WAIT_L(0); PG8_BAR; PG8_MMA(0, 0, At, B0); PG8_MMA(0, 1, At, B1); PG8_BAR; PG8_SCHED;
            PG8_LDA(At, 0, 1); PG8_STAGE(PG8_SB(0, 0), b2, voffB); PG8_STAGE(PG8_SB(0, 1), b2 + hB, voffB); PG8_STAGE(PG8_SA(0, 0), a2, voffA);
            PG8_WAIT_V(8); PG8_WAIT_L(0); PG8_BAR; PG8_MMA(1, 0, At, B0); PG8_MMA(1, 1, At, B1); PG8_BAR; PG8_SCHED;
            PG8_LDB(B0, 1, 0); PG8_LDB(B1, 1, 1); PG8_SCHED; PG8_LDA(At, 1, 0); PG8_STAGE(PG8_SA(0, 1), a2 + hA, voffA);
            PG8_WAIT_V(8); PG8_WAIT_L(0); PG8_BAR; PG8_MMA(0, 0, At, B0); PG8_MMA(0, 1, At, B1); PG8_BAR; PG8_SCHED;
            PG8_LDA(At, 1, 1); PG8_STAGE(PG8_SB(1, 0), b3, voffB); PG8_STAGE(PG8_SB(1, 1), b3 + hB, voffB); PG8_STAGE(PG8_SA(1, 0), a3, voffA);
            PG8_WAIT_V(8); PG8_WAIT_L(0); PG8_BAR; PG8_MMA(1, 0, At, B0); PG8_MMA(1, 1, At, B1); PG8_BAR; PG8_SCHED;
        }
        if (wr == 0) PG8_BAR;
        E(acc, cur, wr, wc, fr, fq);
        if (!has_next) break;
#pragma unroll
        for (int a = 0; a < 2; ++a)
#pragma unroll
            for (int b = 0; b < 2; ++b)
#pragma unroll
                for (int m = 0; m < 4; ++m)
#pragma unroll
                    for (int n = 0; n < 2; ++n) acc[a][b][m][n] = (f32x4){0.f, 0.f, 0.f, 0.f};
        cur = nxt; cA = nA; cB = nB; ++ui;
        if (wr == 1) PG8_BAR;
    }
    PG8_WAIT_V(0);
    PG8_BAR;
#undef PG8_SA
#undef PG8_SB
#undef PG8_STAGE
#undef PG8_LDA
#undef PG8_LDB
#undef PG8_MMA
#undef PG8_WAIT_V
#undef PG8_WAIT_L
#undef PG8_BAR
#undef PG8_SCHED
}
}

using pg8::bf16_t; using pg8::f32x4; using pg8::u32x4; using pg8::u32x2; using pg8::bf16x8; using pg8::Unit; using pg8::cvt_pk_bf16;
#define LAS __attribute__((address_space(3)))

constexpr int DM = 1024, BATCH = 8, SEQ = 4096, DEPTH = 4, MTOK = BATCH * SEQ;
constexpr int DSSM = 512, NG = 32, GH = 16, NP = 64, DSGU = 512, NHEAD = 8, SBLK = 128, DIN = 1536, DFF = 2816, PLE = 256;
constexpr int TC = 32;
constexpr int NROW = MTOK / TC;
constexpr int NCH = SEQ / TC;
constexpr int UAP = TC * GH + 2 * NP;
constexpr float ALPHA = 1.681792830507429f;
constexpr float LN_EPS = 1e-5f;
constexpr int NWAVES = 8, NTHR = 512;
constexpr int LDS_BYTES = 147456 + 64, LDS_MISC = 147456;

constexpr size_t MiB = 1u << 20;
constexpr size_t WS_WIN = 0, WS_WGLU = 12 * MiB, WS_WOUT = 14 * MiB, WS_WGU = 22 * MiB, WS_WD = 66 * MiB, WS_WPLE = 88 * MiB, WS_WPG = 90 * MiB, WS_WSGU = 98 * MiB;
constexpr size_t WS_E = 99 * MiB, WS_BBAR = 102 * MiB, WS_KS = 103 * MiB;
constexpr size_t WS_KM = 108 * MiB, WS_PT = 128 * MiB, WS_PBF = 136 * MiB, WS_H = 152 * MiB;
constexpr size_t WS_R = 216 * MiB;
constexpr int GPP = PLE + DFF;
constexpr size_t WS_G = WS_R, WS_GT = WS_R + 192 * MiB;
constexpr size_t WS_UA = WS_R, WS_US = WS_R + 40 * MiB, WS_VT = WS_R + 72 * MiB, WS_SLOC = WS_R + 104 * MiB, WS_YMIX = WS_R + 120 * MiB;
constexpr size_t WS_CTL = WS_R + 256 * MiB, CTL_BYTES = 6 * MiB;
constexpr size_t WS_CSI = WS_CTL + 65536;
constexpr size_t WS_ST = WS_CTL + MiB;
constexpr size_t WS_SSQ = WS_CTL + 5 * MiB + 512 * 1024;
constexpr size_t WS_CS = WS_CTL + 6 * MiB;
constexpr size_t WS_END = WS_CTL + 7 * MiB;
constexpr int CSO_IN = 0, BWO_IN = 1536, CSO_PG = 3072, BWO_PG = 4096, CSO_GU = 5120, BWO_GU = 10752, CS_L = 16384;

constexpr int N_PHASES_C = 2 + 8 * 4 + 1;
struct Args { const float* in[31]; float* out; unsigned char* ws; int lo, hi; };

__device__ __forceinline__ float bf_lo(unsigned w) { return __uint_as_float(w << 16); }
__device__ __forceinline__ float bf_hi(unsigned w) { return __uint_as_float(w & 0xffff0000u); }
__device__ __forceinline__ float sigm(float x) { return __builtin_amdgcn_rcpf(1.f + __builtin_amdgcn_exp2f(-1.4426950408889634f * x)); }
__device__ __forceinline__ float gelu_t(float x) { const float u = x * (1.f + 0.044715f * x * x); return x * __builtin_amdgcn_rcpf(1.f + __builtin_amdgcn_exp2f(-2.3022081985f * u)); }
__device__ __forceinline__ float wave_sum(float v) {
#pragma unroll
    for (int o = 1; o < 64; o <<= 1) v += __shfl_xor(v, o);
    return v;
}
__device__ __forceinline__ u32x4 pack8(const f32x4& a, const f32x4& b) { u32x4 w; w.x = cvt_pk_bf16(a[0], a[1]); w.y = cvt_pk_bf16(a[2], a[3]); w.z = cvt_pk_bf16(b[0], b[1]); w.w = cvt_pk_bf16(b[2], b[3]); return w; }

struct RowStat { float mu, rs; };
typedef long long i64;
__device__ __forceinline__ RowStat row_stat(const i64* ST, int r) { const i64 ta = ST[2 * r], tq = ST[2 * r + 1]; const float mu = (float)ta * (1.f / (1024.f * 16777216.f)); const float var = fmaxf((float)tq * (1.f / (1024.f * 16777216.f)) - mu * mu, 0.f); RowStat o; o.mu = mu; o.rs = 1.f / sqrtf(var + LN_EPS); return o; }
__device__ __forceinline__ void row_stats8(const i64* ST, int row0, RowStat (&rs)[8]) {
    i64 ta[8], tq[8];
#pragma unroll
    for (int i = 0; i < 8; ++i) { const int r = row0 + (i >> 2) * 128 + (i & 3) * 16; ta[i] = ST[2 * r]; tq[i] = ST[2 * r + 1]; }
#pragma unroll
    for (int i = 0; i < 8; ++i) { const float mu = (float)ta[i] * (1.f / (1024.f * 16777216.f)); const float var = fmaxf((float)tq[i] * (1.f / (1024.f * 16777216.f)) - mu * mu, 0.f); rs[i].mu = mu; rs[i].rs = 1.f / sqrtf(var + LN_EPS); }
}
__device__ __forceinline__ LAS float* red_ptr() { extern __shared__ __attribute__((aligned(16))) unsigned char lds_raw[]; return (LAS float*)((LAS unsigned char*)lds_raw + 131072); }
__device__ __forceinline__ void wg_reduce_rows(LAS float* RED, const float (&a)[8], const float (&q)[8], int wr, int wc, int fr, int fq, float& oa, float& oq) {
#pragma unroll
    for (int i = 0; i < 8; ++i) { float x = a[i], y = q[i]; x += __shfl_xor(x, 16); x += __shfl_xor(x, 32); y += __shfl_xor(y, 16); y += __shfl_xor(y, 32);
        if (fq == 0) { const int rl = (i >> 2) * 128 + wr * 64 + (i & 3) * 16 + fr; RED[(rl * 4 + wc) * 2] = x; RED[(rl * 4 + wc) * 2 + 1] = y; } }
    asm volatile("s_waitcnt lgkmcnt(0)" ::: "memory"); __builtin_amdgcn_s_barrier(); asm volatile("" ::: "memory");
    const int t = (wr * 4 + wc) * 64 + fq * 16 + fr; oa = 0.f; oq = 0.f;
    if (t < 256) { const f32x4 u = *(LAS f32x4*)(RED + t * 8), v = *(LAS f32x4*)(RED + t * 8 + 4); oa = (u[0] + u[2]) + (v[0] + v[2]); oq = (u[1] + u[3]) + (v[1] + v[3]); }
    asm volatile("s_waitcnt lgkmcnt(0)" ::: "memory"); __builtin_amdgcn_s_barrier(); asm volatile("" ::: "memory");
}
typedef const f32x4 (&AccRef)[2][2][4][2];
struct EpiWin { static constexpr bool PERM = true; static constexpr int MID_T = -1;
    bf16_t* UA; bf16_t* US; const i64* ST; const float* cs; const float* bw;
    __device__ __forceinline__ void operator()(AccRef acc, const Unit& u, int wr, int wc, int fr, int fq) const {
        const int row0 = u.pm * 256 + wr * 64 + fr, col0 = u.pn * 256 + wc * 32 + 8 * fq;
        RowStat rs8[8]; row_stats8(ST, row0, rs8);
#pragma unroll
        for (int bj = 0; bj < 2; ++bj) { const int c = col0 + bj * 128;
            const f32x4 c0 = *(const f32x4*)(cs + c), c1 = *(const f32x4*)(cs + c + 4), b0 = *(const f32x4*)(bw + c), b1 = *(const f32x4*)(bw + c + 4);
#pragma unroll
            for (int ai = 0; ai < 2; ++ai)
#pragma unroll
                for (int m = 0; m < 4; ++m) { const int r = row0 + ai * 128 + m * 16; const RowStat rs = rs8[ai * 4 + m];
                    f32x4 v0 = (acc[ai][bj][m][0] - c0 * rs.mu) * rs.rs + b0, v1 = (acc[ai][bj][m][1] - c1 * rs.mu) * rs.rs + b1;
                    if (u.pn < 2) { *(u32x4*)(UA + ((size_t)(c >> 4) * NROW + (r >> 5)) * UAP + (r & 31) * 16 + (c & 15)) = pack8(v0, v1); }
                    else {
#pragma unroll
                        for (int j = 0; j < 4; ++j) { v0[j] = gelu_t(v0[j]); v1[j] = gelu_t(v1[j]); }
                        *(u32x4*)(US + (size_t)r * DSGU + (c - 512)) = pack8(v0, v1); }
                    asm volatile("" ::: "memory"); } }
    }
};
struct EpiVT { static constexpr bool PERM = true; static constexpr int MID_T = -1;
    bf16_t* VT; const i64* ST; const float* cs; const float* bw;
    __device__ __forceinline__ void operator()(AccRef acc, const Unit& u, int wr, int wc, int fr, int fq) const {
        const int row0 = u.pm * 256 + wr * 64 + fr, col0 = u.pn * 256 + wc * 32 + 8 * fq;
#pragma unroll
        for (int bj = 0; bj < 2; ++bj) { const int c = col0 + bj * 128; float mu[8], rsd[8];
#pragma unroll
            for (int j = 0; j < 8; ++j) { const RowStat t = row_stat(ST, c + j); mu[j] = t.mu; rsd[j] = t.rs; }
#pragma unroll
            for (int ai = 0; ai < 2; ++ai)
#pragma unroll
                for (int m = 0; m < 4; ++m) { const int r = row0 + ai * 128 + m * 16; const float cc = cs[r], bb = bw[r]; f32x4 v0, v1;
#pragma unroll
                    for (int j = 0; j < 4; ++j) { v0[j] = gelu_t((acc[ai][bj][m][0][j] - cc * mu[j]) * rsd[j] + bb); v1[j] = gelu_t((acc[ai][bj][m][1][j] - cc * mu[4 + j]) * rsd[4 + j] + bb); }
                    *(u32x4*)(VT + ((size_t)(c >> 7) * 512 + r) * 128 + (c & 127)) = pack8(v0, v1);
                    asm volatile("" ::: "memory"); } }
    }
};
struct EpiGate { static constexpr bool PERM = true; static constexpr int MID_T = -1;
    bf16_t* GT; const float* bias; const i64* ST; const float* cs; const float* bw;
    __device__ __forceinline__ void operator()(AccRef acc, const Unit& u, int wr, int wc, int fr, int fq) const {
        const int row0 = u.pm * 256 + wr * 64 + fr, col0 = u.pn * 256 + wc * 32 + 8 * fq;
        RowStat rs8[8]; row_stats8(ST, row0, rs8);
#pragma unroll
        for (int bj = 0; bj < 2; ++bj) { const int c = col0 + bj * 128;
            const f32x4 c0 = *(const f32x4*)(cs + c), c1 = *(const f32x4*)(cs + c + 4);
            const f32x4 b0 = *(const f32x4*)(bw + c) + *(const f32x4*)(bias + c), b1 = *(const f32x4*)(bw + c + 4) + *(const f32x4*)(bias + c + 4);
#pragma unroll
            for (int ai = 0; ai < 2; ++ai)
#pragma unroll
                for (int m = 0; m < 4; ++m) { const int r = row0 + ai * 128 + m * 16; const RowStat rs = rs8[ai * 4 + m];
                    f32x4 v0 = (acc[ai][bj][m][0] - c0 * rs.mu) * rs.rs + b0, v1 = (acc[ai][bj][m][1] - c1 * rs.mu) * rs.rs + b1;
#pragma unroll
                    for (int j = 0; j < 4; ++j) { v0[j] = sigm(v0[j]); v1[j] = sigm(v1[j]); }
                    __builtin_nontemporal_store(pack8(v0, v1), (u32x4*)(GT + (size_t)r * DM + c));
                    asm volatile("" ::: "memory"); } }
    }
};
template <int ACT> struct EpiBf { static constexpr bool PERM = true; static constexpr int MID_T = -1;
    bf16_t* O; int ldc; const float* bias;
    __device__ __forceinline__ void operator()(AccRef acc, const Unit& u, int wr, int wc, int fr, int fq) const {
        const int row0 = u.pm * 256 + wr * 64 + fr, col0 = u.pn * 256 + wc * 32 + 8 * fq;
        f32x4 bv[2][2];
#pragma unroll
        for (int bj = 0; bj < 2; ++bj)
#pragma unroll
            for (int n = 0; n < 2; ++n) bv[bj][n] = (ACT == 2) ? *(const f32x4*)(bias + col0 + bj * 128 + 4 * n) : (f32x4){0.f, 0.f, 0.f, 0.f};
#pragma unroll
        for (int ai = 0; ai < 2; ++ai)
#pragma unroll
            for (int m = 0; m < 4; ++m) { bf16_t* rowp = O + (size_t)(row0 + ai * 128 + m * 16) * ldc + col0;
#pragma unroll
                for (int bj = 0; bj < 2; ++bj) { f32x4 v0 = acc[ai][bj][m][0] + bv[bj][0], v1 = acc[ai][bj][m][1] + bv[bj][1];
#pragma unroll
                    for (int j = 0; j < 4; ++j) { if (ACT == 1) { v0[j] = gelu_t(v0[j]); v1[j] = gelu_t(v1[j]); } if (ACT == 2) { v0[j] = sigm(v0[j]); v1[j] = sigm(v1[j]); } }
                    *(u32x4*)(rowp + bj * 128) = pack8(v0, v1); }
                asm volatile("" ::: "memory"); }
    }
};
struct EpiSloc { static constexpr bool PERM = false; static constexpr int MID_T = -1;
    float* SL;
    __device__ __forceinline__ void operator()(AccRef acc, const Unit& u, int wr, int wc, int fr, int fq) const {
        const int row0 = u.pm * 256 + wr * 64 + fr, col0 = wc * 32 + 4 * fq;
#pragma unroll
        for (int ai = 0; ai < 2; ++ai)
#pragma unroll
            for (int m = 0; m < 4; ++m) { float* rowp = SL + (size_t)(row0 + ai * 128 + m * 16) * 128 + col0;
#pragma unroll
                for (int n = 0; n < 2; ++n) *(f32x4*)(rowp + n * 16) = acc[ai][0][m][n]; }
    }
};
struct EpiY { static constexpr bool PERM = true; static constexpr int MID_T = -1;
    bf16_t* YA; int g;
    __device__ __forceinline__ void operator()(AccRef acc, const Unit& u, int wr, int wc, int fr, int fq) const {
        const int row0 = u.pm * 256 + wr * 64 + fr, col0 = u.pn * 256 + wc * 32 + 8 * fq;
#pragma unroll
        for (int ai = 0; ai < 2; ++ai)
#pragma unroll
            for (int m = 0; m < 4; ++m) { const int R = row0 + ai * 128 + m * 16;
#pragma unroll
                for (int bj = 0; bj < 2; ++bj) { const int n = col0 + bj * 128; f32x4 v0 = acc[ai][bj][m][0], v1 = acc[ai][bj][m][1];
#pragma unroll
                    for (int j = 0; j < 4; ++j) { v0[j] = gelu_t(v0[j]); v1[j] = gelu_t(v1[j]); }
                    *(u32x4*)(YA + (size_t)(R * TC + (n >> 4)) * DSSM + g * 16 + (n & 15)) = pack8(v0, v1); }
                asm volatile("" ::: "memory"); }
    }
};
struct EpiGlu { static constexpr bool PERM = true; static constexpr int MID_T = -1;
    const bf16_t* YA; bf16_t* YM; i64* SSQ;
    __device__ __forceinline__ void operator()(AccRef acc, const Unit& u, int wr, int wc, int fr, int fq) const {
        const int row0 = u.pm * 256 + wr * 64 + fr, col0 = u.pn * 256 + wc * 32 + 8 * fq;
        float qq[8], zz[8];
#pragma unroll
        for (int i = 0; i < 8; ++i) { qq[i] = 0.f; zz[i] = 0.f; }
#pragma unroll
        for (int ai = 0; ai < 2; ++ai)
#pragma unroll
            for (int m = 0; m < 4; ++m) { const int r = row0 + ai * 128 + m * 16; const size_t off = (size_t)r * DSSM + col0; float q = 0.f;
#pragma unroll
                for (int bj = 0; bj < 2; ++bj) { const u32x4 y = *(const u32x4*)(YA + off + bj * 128); f32x4 v0 = acc[ai][bj][m][0], v1 = acc[ai][bj][m][1];
                    v0[0] = bf_lo(y.x) * sigm(v0[0]); v0[1] = bf_hi(y.x) * sigm(v0[1]); v0[2] = bf_lo(y.y) * sigm(v0[2]); v0[3] = bf_hi(y.y) * sigm(v0[3]);
                    v1[0] = bf_lo(y.z) * sigm(v1[0]); v1[1] = bf_hi(y.z) * sigm(v1[1]); v1[2] = bf_lo(y.w) * sigm(v1[2]); v1[3] = bf_hi(y.w) * sigm(v1[3]);
                    q += ((v0[0] * v0[0] + v0[1] * v0[1]) + (v0[2] * v0[2] + v0[3] * v0[3])) + ((v1[0] * v1[0] + v1[1] * v1[1]) + (v1[2] * v1[2] + v1[3] * v1[3]));
                    *(u32x4*)(YM + (size_t)r * DM + col0 + bj * 128) = pack8(v0, v1); }
                qq[ai * 4 + m] = q;
                if (m == 3) asm volatile("" ::: "memory"); }
        float oa, oq; wg_reduce_rows(red_ptr(), zz, qq, wr, wc, fr, fq, oa, oq);
        const int t = (wr * 4 + wc) * 64 + fq * 16 + fr; if (t < 256) (void)__hip_atomic_fetch_add(SSQ + u.pm * 256 + t, (i64)(oq * 16777216.f), __ATOMIC_RELAXED, __HIP_MEMORY_SCOPE_AGENT);
    }
};
template <bool HAS_PLE, bool OUT_F32> struct EpiRes { static constexpr bool PERM = true; static constexpr int MID_T = HAS_PLE ? 4 : 8;
    __device__ __forceinline__ void mid(f32x4 (&acc)[2][2][4][2], const Unit& u, int wr, int wc, int fr, int fq) const {
        asm volatile("" : "+v"(fr), "+v"(fq));
        const int row0 = u.pm * 256 + wr * 64 + fr, col0 = u.pn * 256 + wc * 32 + 8 * fq;
        if constexpr (!HAS_PLE) {
#pragma unroll
            for (int ai = 0; ai < 2; ++ai)
#pragma unroll
                for (int m = 0; m < 4; ++m) { const float sc = 1.f / sqrtf((float)SSQ[row0 + ai * 128 + m * 16] * (1.f / (512.f * 16777216.f)) + LN_EPS);
#pragma unroll
                    for (int bj = 0; bj < 2; ++bj) { acc[ai][bj][m][0] = acc[ai][bj][m][0] * sc; acc[ai][bj][m][1] = acc[ai][bj][m][1] * sc; } }
            return; }
#pragma unroll
        for (int ai = 0; ai < 2; ++ai)
#pragma unroll
            for (int m = 0; m < 4; ++m)
#pragma unroll
                for (int bj = 0; bj < 2; ++bj) { const u32x4 y = *(const u32x4*)(PL + (size_t)(row0 + ai * 128 + m * 16) * DM + col0 + bj * 128);
                    acc[ai][bj][m][0][0] *= bf_lo(y.x); acc[ai][bj][m][0][1] *= bf_hi(y.x); acc[ai][bj][m][0][2] *= bf_lo(y.y); acc[ai][bj][m][0][3] *= bf_hi(y.y);
                    acc[ai][bj][m][1][0] *= bf_lo(y.z); acc[ai][bj][m][1][1] *= bf_hi(y.z); acc[ai][bj][m][1][2] *= bf_lo(y.w); acc[ai][bj][m][1][3] *= bf_hi(y.w);
                    if (bj == 1 && (m & 1)) asm volatile("" ::: "memory"); }
    }
    bf16_t* Hh; const bf16_t* PL; float* Xf; const i64* STin; const float* gin; const float* bin; i64* STout; const i64* SSQ;
    __device__ __forceinline__ void operator()(AccRef acc, const Unit& u, int wr, int wc, int fr, int fq) const {
        const int row0 = u.pm * 256 + wr * 64 + fr, col0 = u.pn * 256 + wc * 32 + 8 * fq;
        float ssum[8], ssq[8];
#pragma unroll
        for (int i = 0; i < 8; ++i) { ssum[i] = 0.f; ssq[i] = 0.f; }
        RowStat rs8[8]; row_stats8(STin, row0, rs8);
#pragma unroll
        for (int bj = 0; bj < 2; ++bj) { const int c = col0 + bj * 128;
            const f32x4 g0 = *(const f32x4*)(gin + c), g1 = *(const f32x4*)(gin + c + 4), b0 = *(const f32x4*)(bin + c), b1 = *(const f32x4*)(bin + c + 4);
#pragma unroll
            for (int ai = 0; ai < 2; ++ai)
#pragma unroll
                for (int m = 0; m < 4; ++m) { const int r = row0 + ai * 128 + m * 16; const size_t o = (size_t)r * DM + c; const RowStat rs = rs8[ai * 4 + m];
                    const u32x4 hh = *(const u32x4*)(Hh + o);
                    f32x4 h0 = {bf_lo(hh.x), bf_hi(hh.x), bf_lo(hh.y), bf_hi(hh.y)}, h1 = {bf_lo(hh.z), bf_hi(hh.z), bf_lo(hh.w), bf_hi(hh.w)};
                    h0 = (h0 - rs.mu) * rs.rs * g0 + b0; h1 = (h1 - rs.mu) * rs.rs * g1 + b1;
                    f32x4 v0 = h0 * ALPHA + acc[ai][bj][m][0], v1 = h1 * ALPHA + acc[ai][bj][m][1];
                    if (OUT_F32) { *(f32x4*)(Xf + o) = v0; *(f32x4*)(Xf + o + 4) = v1; }
                    else { *(u32x4*)(Hh + o) = pack8(v0, v1);
                        ssum[ai * 4 + m] += ((v0[0] + v0[1]) + (v0[2] + v0[3])) + ((v1[0] + v1[1]) + (v1[2] + v1[3]));
                        ssq[ai * 4 + m] += ((v0[0] * v0[0] + v0[1] * v0[1]) + (v0[2] * v0[2] + v0[3] * v0[3])) + ((v1[0] * v1[0] + v1[1] * v1[1]) + (v1[2] * v1[2] + v1[3] * v1[3])); }
                    if (m == 3 && ai == 1) asm volatile("" ::: "memory"); } }
        if (!OUT_F32) { float oa, oq; wg_reduce_rows(red_ptr(), ssum, ssq, wr, wc, fr, fq, oa, oq);
            const int t = (wr * 4 + wc) * 64 + fq * 16 + fr;
            if (t < 256) { const int r = u.pm * 256 + t; (void)__hip_atomic_fetch_add(STout + 2 * r, (i64)(oa * 16777216.f), __ATOMIC_RELAXED, __HIP_MEMORY_SCOPE_AGENT); (void)__hip_atomic_fetch_add(STout + 2 * r + 1, (i64)(oq * 16777216.f), __ATOMIC_RELAXED, __HIP_MEMORY_SCOPE_AGENT); } }
    }
};
struct EpiPle { static constexpr bool PERM = true; static constexpr int MID_T = -1;
    bf16_t* GT;
    __device__ __forceinline__ void operator()(AccRef acc, const Unit& u, int wr, int wc, int fr, int fq) const {
        const int row0 = u.pm * 256 + wr * 64 + fr, col0 = u.pn * 256 + wc * 32 + 8 * fq;
#pragma unroll
        for (int ai = 0; ai < 2; ++ai)
#pragma unroll
            for (int m = 0; m < 4; ++m) { const size_t off = (size_t)(row0 + ai * 128 + m * 16) * DM + col0;
#pragma unroll
                for (int bj = 0; bj < 2; ++bj) { const u32x4 y = *(const u32x4*)(GT + off + bj * 128); f32x4 v0 = acc[ai][bj][m][0], v1 = acc[ai][bj][m][1];
                    v0[0] *= bf_lo(y.x); v0[1] *= bf_hi(y.x); v0[2] *= bf_lo(y.y); v0[3] *= bf_hi(y.y);
                    v1[0] *= bf_lo(y.z); v1[1] *= bf_hi(y.z); v1[2] *= bf_lo(y.w); v1[3] *= bf_hi(y.w);
                    *(u32x4*)(GT + off + bj * 128) = pack8(v0, v1); }
                asm volatile("" ::: "memory"); }
    }
};
struct EpiGU { static constexpr bool PERM = true; static constexpr int MID_T = -1;
    bf16_t* G; const i64* ST; const float* cs; const float* bw;
    __device__ __forceinline__ void operator()(AccRef acc, const Unit& u, int wr, int wc, int fr, int fq) const {
        const int row0 = u.pm * 256 + wr * 64 + fr, col0 = u.pn * 128 + wc * 32 + 8 * fq, cg = u.pn * 256 + wc * 32 + 8 * fq;
        const f32x4 cg0 = *(const f32x4*)(cs + cg), cg1 = *(const f32x4*)(cs + cg + 4), bg0 = *(const f32x4*)(bw + cg), bg1 = *(const f32x4*)(bw + cg + 4);
        const f32x4 cu0 = *(const f32x4*)(cs + cg + 128), cu1 = *(const f32x4*)(cs + cg + 132), bu0 = *(const f32x4*)(bw + cg + 128), bu1 = *(const f32x4*)(bw + cg + 132);
        RowStat rs8[8]; row_stats8(ST, row0, rs8);
#pragma unroll
        for (int ai = 0; ai < 2; ++ai)
#pragma unroll
            for (int m = 0; m < 4; ++m) { const int r = row0 + ai * 128 + m * 16; const RowStat rs = rs8[ai * 4 + m];
                const f32x4 ga = (acc[ai][0][m][0] - cg0 * rs.mu) * rs.rs + bg0, gb = (acc[ai][0][m][1] - cg1 * rs.mu) * rs.rs + bg1;
                const f32x4 ua = (acc[ai][1][m][0] - cu0 * rs.mu) * rs.rs + bu0, ub = (acc[ai][1][m][1] - cu1 * rs.mu) * rs.rs + bu1;
                f32x4 v0, v1;
#pragma unroll
                for (int j = 0; j < 4; ++j) { v0[j] = ga[j] * sigm(ga[j]) * ua[j]; v1[j] = gb[j] * sigm(gb[j]) * ub[j]; }
                __builtin_nontemporal_store(pack8(v0, v1), (u32x4*)(G + (size_t)r * GPP + PLE + col0));
                asm volatile("" ::: "memory"); }
    }
};

__device__ __forceinline__ unsigned f2bf(float f) { unsigned u = __builtin_bit_cast(unsigned, f); return (u + 0x7fffu + ((u >> 16) & 1u)) >> 16; }
__device__ __forceinline__ unsigned pk2(float lo, float hi) { return f2bf(lo) | (f2bf(hi) << 16); }
__device__ __forceinline__ void transpose_item(const float* W, int K, int N, bf16_t* WT, int k0, int n0, int dst_row0, LAS float* scr, int lane, const float* gk = nullptr, const float* bk = nullptr, i64* cs = nullptr, i64* bw = nullptr, int ldw = 0, int koff = 0) {
    if (ldw == 0) ldw = K;
#pragma unroll 8
    for (int i = 0; i < 32; ++i) { const int kk = 2 * i + (lane >> 5); scr[kk * 33 + (lane & 31)] = W[(size_t)(k0 + kk) * N + n0 + (lane & 31)]; }
    asm volatile("s_waitcnt lgkmcnt(0)" ::: "memory");
    const int c = lane & 7;
    float gs[8];
#pragma unroll
    for (int i = 0; i < 8; ++i) gs[i] = gk ? gk[k0 + 8 * c + i] : 1.f;
    if (gk && cs) { const int n = lane & 31; const float* vv = (lane < 32) ? gk : bk; float a = 0.f;
#pragma unroll 8
        for (int kk = 0; kk < 64; ++kk) a += scr[kk * 33 + n] * vv[k0 + kk];
        (void)__hip_atomic_fetch_add(((lane < 32) ? cs : bw) + dst_row0 + n, (i64)(a * 4294967296.f), __ATOMIC_RELAXED, __HIP_MEMORY_SCOPE_AGENT); }
#pragma unroll
    for (int j = 0; j < 4; ++j) { const int n = (lane >> 3) + 8 * j; const LAS float* sp = scr + (8 * c) * 33 + n;
        u32x4 o; o.x = pk2(sp[0 * 33] * gs[0], sp[1 * 33] * gs[1]); o.y = pk2(sp[2 * 33] * gs[2], sp[3 * 33] * gs[3]); o.z = pk2(sp[4 * 33] * gs[4], sp[5 * 33] * gs[5]); o.w = pk2(sp[6 * 33] * gs[6], sp[7 * 33] * gs[7]);
        *(u32x4*)(WT + (size_t)(dst_row0 + n) * ldw + koff + k0 + 8 * c) = o; }
    asm volatile("s_waitcnt lgkmcnt(0)" ::: "memory");
}
__device__ __forceinline__ void raw_row(const float* xrow, bf16_t* brow, i64* st, int lane) {
    const f32x4* xr = (const f32x4*)xrow + lane; float a = 0.f, q = 0.f;
#pragma unroll
    for (int j = 0; j < 4; ++j) { const f32x4 v = xr[64 * j]; a += (v[0] + v[1]) + (v[2] + v[3]); q += (v[0] * v[0] + v[1] * v[1]) + (v[2] * v[2] + v[3] * v[3]);
        u32x2 w; w.x = cvt_pk_bf16(v[0], v[1]); w.y = cvt_pk_bf16(v[2], v[3]); ((u32x2*)brow)[lane + 64 * j] = w; }
    a = wave_sum(a); q = wave_sum(q);
    if (lane == 0) { st[0] = (i64)(a * 16777216.f); st[1] = (i64)(q * 16777216.f); }
}
template <bool WF32, bool WBF>
__device__ __forceinline__ void ln_row(const float* xrow, const float* g, const float* b, float* frow, bf16_t* brow, int lane) {
    const f32x4* xr = (const f32x4*)xrow + lane;
    f32x4 v[4]; float s = 0.f;
#pragma unroll
    for (int j = 0; j < 4; ++j) { v[j] = xr[64 * j]; s += (v[j][0] + v[j][1]) + (v[j][2] + v[j][3]); }
    const float mean = wave_sum(s) * (1.f / DM); float s2 = 0.f;
#pragma unroll
    for (int j = 0; j < 4; ++j) { v[j] = v[j] - mean; s2 += (v[j][0] * v[j][0] + v[j][1] * v[j][1]) + (v[j][2] * v[j][2] + v[j][3] * v[j][3]); }
    const float rstd = 1.f / sqrtf(wave_sum(s2) * (1.f / DM) + LN_EPS);
#pragma unroll
    for (int j = 0; j < 4; ++j) { const f32x4 gg = ((const f32x4*)g)[lane + 64 * j], bb = ((const f32x4*)b)[lane + 64 * j]; const f32x4 o = v[j] * rstd * gg + bb;
        if (WF32) ((f32x4*)frow)[lane + 64 * j] = o; if (WBF) { u32x2 w; w.x = cvt_pk_bf16(o[0], o[1]); w.y = cvt_pk_bf16(o[2], o[3]); ((u32x2*)brow)[lane + 64 * j] = w; } }
}


#define XB_TMO      128
#define XB_XCNT(j)  (256  + 64 * (j))
#define XB_XSUB(j)  (1280 + 64 * (j))
#define XB_XGEN(j)  (2304 + 64 * (j))
#define XB_TOP      3328
#define XB_TOPGEN   3392
#define XCD_BAR_WORDS 3456
#define XB_SPIN_CAP (1u << 20)
__device__ __forceinline__ unsigned xb_ld(unsigned* p)              { return __hip_atomic_load(p, __ATOMIC_RELAXED, __HIP_MEMORY_SCOPE_AGENT); }
__device__ __forceinline__ unsigned xb_add(unsigned* p, unsigned v) { return __hip_atomic_fetch_add(p, v, __ATOMIC_RELAXED, __HIP_MEMORY_SCOPE_AGENT); }
__device__ __forceinline__ unsigned xb_xcc_id() { return (unsigned)__builtin_amdgcn_s_getreg((3 << 11) | 20) & 0xFu; }
#define XB_SPIN(cond, bar) do { unsigned _sp = 0; while (cond) { __builtin_amdgcn_s_sleep(1); \
    if ((++_sp & 255u) == 0u) { if (xb_ld(&(bar)[XB_TMO])) break; if (_sp > XB_SPIN_CAP) { atomicAdd(&(bar)[XB_TMO], 1u); break; } } } } while (0)
struct XcdBarrier { unsigned* bar; unsigned x; volatile LAS unsigned* st; };
__device__ __forceinline__ XcdBarrier xcd_barrier_post(unsigned* bar, volatile LAS unsigned* st) {
    XcdBarrier b; b.bar = bar; b.x = xb_xcc_id(); b.st = st;
    if (threadIdx.x == 0) (void)xb_add(&bar[XB_XCNT(b.x)], 1u);
    return b;
}
__device__ __forceinline__ void xcd_barrier_complete(unsigned* bar, unsigned x, unsigned& nloc, unsigned& nx) {
    const unsigned G = gridDim.x * gridDim.y * gridDim.z;
    unsigned sum, cnt, mine, sp = 0u;
    for (;;) {
        sum = 0u; cnt = 0u; mine = 0u;
#pragma unroll
        for (unsigned j = 0; j < 16; ++j) { const unsigned c = xb_ld(&bar[XB_XCNT(j)]); sum += c; cnt += (c > 0u) ? 1u : 0u; mine = (j == x) ? c : mine; }
        if (sum == G) break;
        __builtin_amdgcn_s_sleep(1);
        if ((++sp & 255u) == 0u) { if (xb_ld(&bar[XB_TMO])) break; if (sp > XB_SPIN_CAP) { atomicAdd(&bar[XB_TMO], 1u); break; } }
    }
    nloc = mine > 0u ? mine : 1u; nx = cnt > 0u ? cnt : 1u;
}
__device__ __forceinline__ void xcd_barrier(const XcdBarrier& b) {
    asm volatile("s_waitcnt vmcnt(0)" ::: "memory");
    __syncthreads();
    if (threadIdx.x == 0) {
        unsigned* bar = b.bar;
        __builtin_amdgcn_s_waitcnt(0);
        unsigned nloc = b.st[0], nx = b.st[1];
        if (nloc == 0u) { xcd_barrier_complete(bar, b.x, nloc, nx); b.st[0] = nloc; b.st[1] = nx; }
        const unsigned old = xb_add(&bar[XB_XSUB(b.x)], 1u);
        const unsigned gen = old / nloc;
        if (old + 1u == (gen + 1u) * nloc) {
            __builtin_amdgcn_fence(__ATOMIC_RELEASE, "agent");
            asm volatile("s_waitcnt vmcnt(0)" ::: "memory");
            const unsigned og = xb_add(&bar[XB_TOP], 1u);
            const unsigned tg = og / nx;
            if (og + 1u == (tg + 1u) * nx) xb_add(&bar[XB_TOPGEN], 1u);
            else XB_SPIN(xb_ld(&bar[XB_TOPGEN]) == tg, bar);
            __builtin_amdgcn_fence(__ATOMIC_ACQUIRE, "agent");
            xb_add(&bar[XB_XGEN(b.x)], 1u);
            asm volatile("s_waitcnt vmcnt(0)" ::: "memory");
        } else {
            XB_SPIN(xb_ld(&bar[XB_XGEN(b.x)]) == gen, bar);
            __builtin_amdgcn_fence(__ATOMIC_ACQUIRE, "agent");
            asm volatile("s_waitcnt vmcnt(0)" ::: "memory");
        }
    }
    __syncthreads();
}

__global__ void __launch_bounds__(NTHR, 2) mega_fwd(Args args) {
    extern __shared__ __attribute__((aligned(16))) unsigned char lds_raw[];
    LAS unsigned char* lds = (LAS unsigned char*)lds_raw;
    cg::grid_group grid = cg::this_grid();
    const int tid0 = threadIdx.x, wave = __builtin_amdgcn_readfirstlane(tid0 >> 6);
    const int G = gridDim.x, bx = blockIdx.x;
    const int gw = bx * NWAVES + wave, NGW = G * NWAVES;
    const size_t NGT = (size_t)G * NTHR;
    unsigned char* ws = args.ws;
    const float* const* in = args.in;
    float* X = args.out;
    bf16_t* H = (bf16_t*)(ws + WS_H);
    bf16_t* WIN = (bf16_t*)(ws + WS_WIN); bf16_t* WGLU = (bf16_t*)(ws + WS_WGLU); bf16_t* WOUT = (bf16_t*)(ws + WS_WOUT); bf16_t* WGU = (bf16_t*)(ws + WS_WGU);
    bf16_t* WD = (bf16_t*)(ws + WS_WD); bf16_t* WPG = (bf16_t*)(ws + WS_WPG); bf16_t* WSGU = (bf16_t*)(ws + WS_WSGU);
    float2* ET = (float2*)(ws + WS_E); float2* BBAR = (float2*)(ws + WS_BBAR); float* KS = (float*)(ws + WS_KS);
    bf16_t* KM = (bf16_t*)(ws + WS_KM); bf16_t* PT = (bf16_t*)(ws + WS_PT);
    bf16_t* GB = (bf16_t*)(ws + WS_G); bf16_t* GT = (bf16_t*)(ws + WS_GT);
    bf16_t* UA = (bf16_t*)(ws + WS_UA); bf16_t* US = (bf16_t*)(ws + WS_US); bf16_t* VT = (bf16_t*)(ws + WS_VT); float* SLOC = (float*)(ws + WS_SLOC); bf16_t* YMIX = (bf16_t*)(ws + WS_YMIX);
    bf16_t* YGLU = US; bf16_t* YACT = VT;
    float* CSV = (float*)(ws + WS_CS); i64* CSI = (i64*)(ws + WS_CSI); i64* STB = (i64*)(ws + WS_ST); i64* SSQB = (i64*)(ws + WS_SSQ);
    const int lo = args.lo, hi = args.hi;
    int ph = 0;
    volatile LAS unsigned* MISC = (volatile LAS unsigned*)(lds + LDS_MISC);
    if (tid0 < 16) MISC[tid0] = 0u;
    __syncthreads();
    XcdBarrier xbar; xbar.bar = (unsigned*)(ws + WS_CTL); xbar.x = 0; xbar.st = MISC;
    if (hi - lo > 1) xbar = xcd_barrier_post((unsigned*)(ws + WS_CTL), MISC);
#define PHASE_BEGIN if (lo <= ph && ph < hi) { const int kind_ = ph < 2 ? ph : (ph == N_PHASES_C - 1 ? 11 : 2 + (ph - 2) % 8); const int nrep_ = ((DOUBLE_MASK >> kind_) & 1) ? 2 : 1; for (int rep_ = 0; rep_ < nrep_; ++rep_) { int tid = tid0; asm volatile("" : "+v"(tid)); const int lane = tid & 63; const size_t gt = (size_t)bx * NTHR + tid; (void)lane; (void)gt;
#define PHASE_END   } if (ph + 1 < hi) { if (ph == 0) grid.sync(); else xcd_barrier(xbar); } } ++ph;

    PHASE_BEGIN
#if !defined(ONLY) || ONLY == 0
    {
        LAS float* scr = (LAS float*)(lds + wave * 16384);
        constexpr int I_IN = 16 * 48, I_GLU = 8 * 16, I_OUT = 16 * 32, I_GA = 16 * 88, I_DN = 44 * 32, I_PLE = 4 * 32, I_PG = 16 * 32;
        constexpr int I_L = I_IN + I_GLU + I_OUT + 2 * I_GA + I_DN + I_PLE + I_PG;
        for (int it = gw; it < DEPTH * I_L; it += NGW) {
            const int l = it / I_L; int r = it % I_L;
            if (r < I_IN) { const int nb = r % 48, kb = r / 48; transpose_item(in[4] + (size_t)l * DM * DIN, DM, DIN, WIN + (size_t)l * DIN * DM, 64 * kb, 32 * nb, 32 * nb, scr, lane, l ? in[29] + (l - 1) * DM : in[2], l ? in[30] + (l - 1) * DM : in[3], CSI + l * CS_L + CSO_IN, CSI + l * CS_L + BWO_IN); continue; } r -= I_IN;
            if (r < I_GLU) { const int nb = r % 16, kb = r / 16; transpose_item(in[13] + (size_t)l * DSSM * DSSM, DSSM, DSSM, WGLU + (size_t)l * DSSM * DSSM, 64 * kb, 32 * nb, 32 * nb, scr, lane); continue; } r -= I_GLU;
            if (r < I_OUT) { const int nb = r % 32, kb = r / 32; transpose_item(in[20] + (size_t)l * DM * DM, DM, DM, WOUT + (size_t)l * DM * DM, 64 * kb, 32 * nb, 32 * nb, scr, lane, kb < 8 ? in[18] + l * DSSM : nullptr); continue; } r -= I_OUT;
            if (r < I_GA) { const int nb = r % 88, kb = r / 88, n0 = 32 * nb; transpose_item(in[23] + (size_t)l * DM * DFF, DM, DFF, WGU + (size_t)l * 2 * DFF * DM, 64 * kb, n0, 256 * (n0 / 128) + (n0 % 128), scr, lane, in[21] + l * DM, in[22] + l * DM, CSI + l * CS_L + CSO_GU, CSI + l * CS_L + BWO_GU); continue; } r -= I_GA;
            if (r < I_GA) { const int nb = r % 88, kb = r / 88, n0 = 32 * nb; transpose_item(in[24] + (size_t)l * DM * DFF, DM, DFF, WGU + (size_t)l * 2 * DFF * DM, 64 * kb, n0, 256 * (n0 / 128) + 128 + (n0 % 128), scr, lane, in[21] + l * DM, in[22] + l * DM, CSI + l * CS_L + CSO_GU, CSI + l * CS_L + BWO_GU); continue; } r -= I_GA;
            if (r < I_DN) { const int nb = r % 32, kb = r / 32; transpose_item(in[25] + (size_t)l * DFF * DM, DFF, DM, WD + (size_t)l * DM * GPP, 64 * kb, 32 * nb, 32 * nb, scr, lane, nullptr, nullptr, nullptr, nullptr, GPP, PLE); continue; } r -= I_DN;
            if (r < I_PLE) { const int nb = r % 32, kb = r / 32; transpose_item(in[26] + (size_t)l * PLE * DM, PLE, DM, WD + (size_t)l * DM * GPP, 64 * kb, 32 * nb, 32 * nb, scr, lane, nullptr, nullptr, nullptr, nullptr, GPP, 0); continue; } r -= I_PLE;
            { const int nb = r % 32, kb = r / 32; transpose_item(in[27] + (size_t)l * DM * DM, DM, DM, WPG + (size_t)l * DM * DM, 64 * kb, 32 * nb, 32 * nb, scr, lane, in[21] + l * DM, in[22] + l * DM, CSI + l * CS_L + CSO_PG, CSI + l * CS_L + BWO_PG); }
        }
        for (int m = gw; m < MTOK; m += NGW) raw_row(in[0] + (size_t)m * DM, H + (size_t)m * DM, STB + 2 * (size_t)m, lane);
        for (size_t i = gt; i < (size_t)DEPTH * NG * NP; i += NGT) {
            const int lg = (int)(i / NP);
            const double dt = exp((double)in[7][lg]);
            const double are = in[5][i], aim = in[6][i];
            const double mag = exp(are * dt), abr = mag * cos(aim * dt), abi = mag * sin(aim * dt);
            const double nr = abr - 1.0, ni = abi, den = are * are + aim * aim;
            const double cr = (nr * are + ni * aim) / den, ci = (ni * are - nr * aim) / den;
            double er = 1.0, ei = 0.0;
            for (int k = 0; k <= TC; ++k) { ET[i * (TC + 1) + k] = make_float2((float)er, (float)ei); const double t = er * abr - ei * abi; ei = er * abi + ei * abr; er = t; }
            for (int h = 0; h < GH; ++h) { const double br = in[8][i * GH + h], bi = in[9][i * GH + h]; BBAR[i * GH + h] = make_float2((float)(cr * br - ci * bi), (float)(cr * bi + ci * br)); }
        }
        for (size_t i = gt; i < (size_t)DEPTH * NHEAD * SBLK * SBLK; i += NGT) { const int jj = (int)(i & 127), ii = (int)((i >> 7) & 127); WSGU[i] = (bf16_t)(((ii >> 6) >= (jj >> 6)) ? f2bf(in[16][i]) : 0u); }
    }
#endif
    PHASE_END
    PHASE_BEGIN
#if !defined(ONLY) || ONLY == 1
    for (size_t i = gt; i < (size_t)DEPTH * CS_L; i += NGT) CSV[i] = (float)((double)CSI[i] * (1.0 / 4294967296.0));
    for (size_t i4 = gt; i4 < (size_t)DEPTH * NG * TC * GH * GH / 4; i4 += NGT) {
        const size_t i = i4 * 4; const int hi0 = (int)(i & 15), ho = (int)((i >> 4) & 15), k = (int)((i >> 8) & 31), lg = (int)(i >> 13);
        const float* cre = in[10] + ((size_t)lg * GH + ho) * NP; const float* cim = in[11] + ((size_t)lg * GH + ho) * NP;
        f32x4 s = {0.f, 0.f, 0.f, 0.f};
#pragma unroll 8
        for (int p = 0; p < NP; ++p) { const float2 e = ET[((size_t)lg * NP + p) * (TC + 1) + k]; const float cr = cre[p], ci = cim[p];
            const float wr_ = cr * e.x - ci * e.y, wi_ = cr * e.y + ci * e.x;
            const f32x4 b01 = *(const f32x4*)(BBAR + ((size_t)lg * NP + p) * GH + hi0), b23 = *(const f32x4*)(BBAR + ((size_t)lg * NP + p) * GH + hi0 + 2);
            s[0] += wr_ * b01[0] - wi_ * b01[1]; s[1] += wr_ * b01[2] - wi_ * b01[3]; s[2] += wr_ * b23[0] - wi_ * b23[1]; s[3] += wr_ * b23[2] - wi_ * b23[3]; }
        if (k == 0 && ho >= hi0 && ho < hi0 + 4) s[ho - hi0] += in[12][lg * GH + ho];
        *(f32x4*)(KS + i) = s;
    }
#endif
    PHASE_END

    for (int l = 0; l < DEPTH; ++l) {
        PHASE_BEGIN
#if !defined(ONLY) || ONLY == 2
        {
            for (size_t e = gt; e < (size_t)NG * 512 * (UAP / 8); e += NGT) {
                const int k8 = (int)(e % (UAP / 8)), n = (int)((e / (UAP / 8)) % 512), g = (int)(e / ((UAP / 8) * 512));
                const int i = n >> 4, ho = n & 15, lg = l * NG + g; float v[8];
                if (k8 < 64) { const int j = k8 >> 1, h0 = (k8 & 1) * 8;
                    if (i >= j) { const float* src = KS + ((((size_t)lg * TC + (i - j)) * GH + ho) * GH + h0);
                        const f32x4 s0 = *(const f32x4*)src, s1 = *(const f32x4*)(src + 4);
#pragma unroll
                        for (int q = 0; q < 4; ++q) { v[q] = s0[q]; v[4 + q] = s1[q]; } }
                    else {
#pragma unroll
                        for (int q = 0; q < 8; ++q) v[q] = 0.f; } }
                else { const int q0 = (k8 - 64) * 8, part = q0 >> 6, p0 = q0 & 63;
                    const float* crp = in[10] + ((size_t)lg * GH + ho) * NP + p0; const float* cip = in[11] + ((size_t)lg * GH + ho) * NP + p0;
                    const f32x4 cr0 = *(const f32x4*)crp, cr1 = *(const f32x4*)(crp + 4), ci0 = *(const f32x4*)cip, ci1 = *(const f32x4*)(cip + 4);
#pragma unroll
                    for (int q = 0; q < 8; ++q) { const int p = p0 + q; const float2 a = ET[((size_t)lg * NP + p) * (TC + 1) + (i + 1)];
                        const float cr = q < 4 ? cr0[q & 3] : cr1[q & 3], ci = q < 4 ? ci0[q & 3] : ci1[q & 3];
                        v[q] = part ? -(cr * a.y + ci * a.x) : (cr * a.x - ci * a.y); } }
                u32x4 w; w.x = pk2(v[0], v[1]); w.y = pk2(v[2], v[3]); w.z = pk2(v[4], v[5]); w.w = pk2(v[6], v[7]);
                *(u32x4*)(KM + ((size_t)g * 512 + n) * UAP + k8 * 8) = w;
            }
            for (size_t e = gt; e < (size_t)NG * 256 * 64; e += NGT) {
                const int k8 = (int)(e & 63), n = (int)((e >> 6) & 255), g = (int)(e >> 14), lg = l * NG + g; float v[8];
                if (n < 128) { const int part = n >> 6, p = n & 63, j = k8 >> 1, h0 = (k8 & 1) * 8; const float2 a = ET[((size_t)lg * NP + p) * (TC + 1) + (TC - 1 - j)];
                    const f32x4* bp = (const f32x4*)(BBAR + ((size_t)lg * NP + p) * GH + h0);
#pragma unroll
                    for (int q2 = 0; q2 < 4; ++q2) { const f32x4 b = bp[q2];
                        v[2 * q2] = part ? (a.x * b[1] + a.y * b[0]) : (a.x * b[0] - a.y * b[1]); v[2 * q2 + 1] = part ? (a.x * b[3] + a.y * b[2]) : (a.x * b[2] - a.y * b[3]); } }
                else {
#pragma unroll
                    for (int q = 0; q < 8; ++q) v[q] = 0.f; }
                u32x4 w; w.x = pk2(v[0], v[1]); w.y = pk2(v[2], v[3]); w.z = pk2(v[4], v[5]); w.w = pk2(v[6], v[7]);
                *(u32x4*)(PT + ((size_t)g * 256 + n) * 512 + k8 * 8) = w;
            }
            { pg8::Gemm g{H, WIN + (size_t)l * DIN * DM, MTOK, 1024, DM, DM, DM}; pg8::StaticOrder S; S.init(MTOK, 1024, G, bx); EpiWin E{UA, US, STB + (size_t)(2 * l) * MTOK * 2, CSV + l * CS_L + CSO_IN, CSV + l * CS_L + BWO_IN}; pg8::gemm_phase(lds, g, S, E); }
            { pg8::Gemm g{WIN + (size_t)l * DIN * DM + (size_t)1024 * DM, H, 512, MTOK, DM, DM, DM}; pg8::StaticOrder S; S.init(512, MTOK, G, bx); EpiVT E{VT, STB + (size_t)(2 * l) * MTOK * 2, CSV + l * CS_L + CSO_IN + 1024, CSV + l * CS_L + BWO_IN + 1024}; pg8::gemm_phase(lds, g, S, E); }
        }
#endif
        PHASE_END
        PHASE_BEGIN
#if !defined(ONLY) || ONLY == 3
        {
            const bf16_t* Wl = WSGU + (size_t)l * NHEAD * SBLK * SBLK;
            const float* lng = in[14] + l * DSGU; const float* lnb = in[15] + l * DSGU; const float* bs = in[17] + l * NHEAD * SBLK; const float* gsg = in[19] + l * DSGU;
            LAS float* ST = (LAS float*)(lds + 139264);
            for (int blk = bx; blk < MTOK / SBLK; blk += G) {
                const int tok0 = blk * SBLK;
                int tst_ = tid; asm volatile("" : "+v"(tst_));
#pragma unroll
                for (int hb = 0; hb < 2; ++hb) { u32x4 stg[8];
#pragma unroll
                    for (int j = 0; j < 8; ++j) { const int idx = tst_ + (hb * 8 + j) * NTHR, ch = idx >> 4, seg = idx & 15; stg[j] = *(const u32x4*)(VT + ((size_t)blk * 512 + ch) * 128 + seg * 8); }
#pragma unroll
                    for (int j = 0; j < 8; ++j) { const int idx = tst_ + (hb * 8 + j) * NTHR, ch = idx >> 4, seg = idx & 15; *(LAS u32x4*)(lds + ch * 272 + seg * 16) = stg[j]; } }
                __syncthreads();
                {
                    float s0 = 0.f, s1 = 0.f, q0 = 0.f, q1 = 0.f;
#pragma unroll 16
                    for (int cc = 0; cc < 64; ++cc) { const unsigned w = *(LAS unsigned*)(lds + (wave * 64 + cc) * 272 + lane * 4); const float a = bf_lo(w), b = bf_hi(w); s0 += a; q0 += a * a; s1 += b; q1 += b * b; }
                    ST[(wave * 64 + lane) * 4 + 0] = s0; ST[(wave * 64 + lane) * 4 + 1] = q0; ST[(wave * 64 + lane) * 4 + 2] = s1; ST[(wave * 64 + lane) * 4 + 3] = q1;
                    __syncthreads();
                    s0 = s1 = q0 = q1 = 0.f;
#pragma unroll
                    for (int o = 0; o < 8; ++o) { const f32x4 t = *(LAS f32x4*)(ST + (o * 64 + lane) * 4); s0 += t[0]; q0 += t[1]; s1 += t[2]; q1 += t[3]; }
                    const float m0 = s0 * (1.f / 512.f), m1 = s1 * (1.f / 512.f);
                    const float r0 = 1.f / sqrtf(fmaxf(q0 * (1.f / 512.f) - m0 * m0, 0.f) + LN_EPS), r1 = 1.f / sqrtf(fmaxf(q1 * (1.f / 512.f) - m1 * m1, 0.f) + LN_EPS);
                    const float gl = lng[wave * 64 + lane], bl = lnb[wave * 64 + lane];
#pragma unroll 8
                    for (int cc = 0; cc < 64; ++cc) { const int ch = wave * 64 + cc; LAS unsigned* pw = (LAS unsigned*)(lds + ch * 272 + lane * 4); const unsigned w = *pw;
                        const float gg = __builtin_bit_cast(float, __builtin_amdgcn_readlane(__builtin_bit_cast(int, gl), cc)), bb = __builtin_bit_cast(float, __builtin_amdgcn_readlane(__builtin_bit_cast(int, bl), cc));
                        *pw = cvt_pk_bf16((bf_lo(w) - m0) * r0 * gg + bb, (bf_hi(w) - m1) * r1 * gg + bb); }
                    __syncthreads();
                }
                {
                    const int fr = lane & 15, fq = lane >> 4, h = wave;
                    f32x4 acc[8][4];
#pragma unroll
                    for (int mt = 0; mt < 8; ++mt)
#pragma unroll
                        for (int nt = 0; nt < 4; ++nt) acc[mt][nt] = (f32x4){0.f, 0.f, 0.f, 0.f};
                    const bf16_t* Wh = Wl + (size_t)h * SBLK * SBLK;
                    bf16x8 afr[8];
#pragma unroll
                    for (int mt = 0; mt < 8; ++mt) afr[mt] = *(const bf16x8*)(Wh + (size_t)(mt * 16 + fr) * SBLK + fq * 8);
#pragma unroll 1
                    for (int ks = 0; ks < 4; ++ks) {
                        bf16x8 bfr[4], anx[8];
#pragma unroll
                        for (int nt = 0; nt < 4; ++nt) bfr[nt] = *(const LAS bf16x8*)(lds + (h * 64 + nt * 16 + fr) * 272 + (ks * 32 + fq * 8) * 2);
#pragma unroll
                        for (int mt = 0; mt < 8; ++mt) anx[mt] = *(const bf16x8*)(Wh + (size_t)(mt * 16 + fr) * SBLK + ((ks + 1) & 3) * 32 + fq * 8);
#pragma unroll
                        for (int mt = 0; mt < 8; ++mt)
#pragma unroll
                            for (int nt = 0; nt < 4; ++nt) acc[mt][nt] = __builtin_amdgcn_mfma_f32_16x16x32_bf16(bfr[nt], afr[mt], acc[mt][nt], 0, 0, 0);
#pragma unroll
                        for (int mt = 0; mt < 8; ++mt) afr[mt] = anx[mt];
                    }
                    float part[8];
#pragma unroll
                    for (int mt = 0; mt < 8; ++mt) { const int i = mt * 16 + fr; const float bias = bs[h * SBLK + i]; float q = 0.f;
#pragma unroll
                        for (int nt = 0; nt < 4; ++nt) { const u32x2 uu = *(const u32x2*)(US + (size_t)(tok0 + i) * DSGU + h * 64 + nt * 16 + fq * 4); f32x4 o = acc[mt][nt] + bias;
                            o[0] *= bf_lo(uu.x); o[1] *= bf_hi(uu.x); o[2] *= bf_lo(uu.y); o[3] *= bf_hi(uu.y); acc[mt][nt] = o; q += (o[0] * o[0] + o[1] * o[1]) + (o[2] * o[2] + o[3] * o[3]); }
                        q += __shfl_xor(q, 16); q += __shfl_xor(q, 32); part[mt] = q; if ((mt & 3) == 3) asm volatile("" ::: "memory"); }
                    if (fq == 0) {
#pragma unroll
                        for (int mt = 0; mt < 8; ++mt) ST[(mt * 16 + fr) * 8 + h] = part[mt]; }
                    __syncthreads();
#pragma unroll
                    for (int mt = 0; mt < 8; ++mt) { const int i = mt * 16 + fr; const f32x4 a = *(LAS f32x4*)(ST + i * 8), b = *(LAS f32x4*)(ST + i * 8 + 4);
                        const float rs = 1.f / sqrtf(((a[0] + a[1]) + (a[2] + a[3]) + (b[0] + b[1]) + (b[2] + b[3])) * (1.f / 512.f) + LN_EPS);
#pragma unroll
                        for (int nt = 0; nt < 4; ++nt) { const int ch = h * 64 + nt * 16 + fq * 4; const f32x4 gg = *(const f32x4*)(gsg + ch); const f32x4 o = acc[mt][nt] * rs * gg;
                            u32x2 w; w.x = cvt_pk_bf16(o[0], o[1]); w.y = cvt_pk_bf16(o[2], o[3]); *(u32x2*)(YMIX + (size_t)(tok0 + i) * DM + 512 + ch) = w; } asm volatile("" ::: "memory"); }
                    __syncthreads();
                }
            }
            for (int un = bx; un < NG * 4; un += G) { const int g = un >> 2, pm = un & 3;
                pg8::Gemm gm{UA + (size_t)g * NROW * UAP, PT + (size_t)g * 256 * 512, NROW, 256, 512, UAP, 512}; pg8::OneUnit S{{pm, 0}}; EpiSloc E{SLOC + (size_t)g * NROW * 128}; pg8::gemm_phase(lds, gm, S, E); }
        }
#endif
        PHASE_END
        PHASE_BEGIN
#if !defined(ONLY) || ONLY == 4
        for (int w = bx; w < BATCH * NG; w += G) {
            const int b = w / NG, g = w % NG, lg = l * NG + g, seg = wave;
            const float2 aT = ET[((size_t)lg * NP + lane) * (TC + 1) + TC];
            const float* sl = SLOC + ((size_t)g * NROW + b * NCH + seg * 16) * 128 + lane;
            bf16_t* ua = UA + ((size_t)g * NROW + b * NCH + seg * 16) * UAP + 512 + lane;
            float lr[16], li[16];
#pragma unroll
            for (int q = 0; q < 16; ++q) { lr[q] = sl[(size_t)q * 128]; li[q] = sl[(size_t)q * 128 + 64]; }
            float sr = 0.f, si = 0.f;
#pragma unroll
            for (int q = 0; q < 16; ++q) { const float tr = aT.x * sr - aT.y * si + lr[q]; si = aT.x * si + aT.y * sr + li[q]; sr = tr; }
            LAS float* EX = (LAS float*)lds;
            EX[(seg * 64 + lane) * 2] = sr; EX[(seg * 64 + lane) * 2 + 1] = si;
            float2 a16 = aT;
#pragma unroll
            for (int q = 0; q < 4; ++q) { const float tr = a16.x * a16.x - a16.y * a16.y; a16.y = 2.f * a16.x * a16.y; a16.x = tr; }
            __syncthreads();
            sr = 0.f; si = 0.f;
            for (int v = 0; v < seg; ++v) { const float ex = EX[(v * 64 + lane) * 2], ey = EX[(v * 64 + lane) * 2 + 1]; const float tr = a16.x * sr - a16.y * si + ex; si = a16.x * si + a16.y * sr + ey; sr = tr; }
#pragma unroll
            for (int q = 0; q < 16; ++q) { ua[(size_t)q * UAP] = (bf16_t)f2bf(sr); ua[(size_t)q * UAP + 64] = (bf16_t)f2bf(si);
                const float tr = aT.x * sr - aT.y * si + lr[q]; si = aT.x * si + aT.y * sr + li[q]; sr = tr; }
            __syncthreads();
        }
#endif
        PHASE_END
        PHASE_BEGIN
#if !defined(ONLY) || ONLY == 5
        for (int un = bx; un < NG * 8; un += G) { const int g = un >> 3, pm = (un & 7) >> 1, pn = un & 1;
            pg8::Gemm gm{UA + (size_t)g * NROW * UAP, KM + (size_t)g * 512 * UAP, NROW, 512, UAP, UAP, UAP}; pg8::OneUnit S{{pm, pn}}; EpiY E{YACT, g}; pg8::gemm_phase(lds, gm, S, E); }
#endif
        PHASE_END
        PHASE_BEGIN
#if !defined(ONLY) || ONLY == 6
        { pg8::Gemm g{YACT, WGLU + (size_t)l * DSSM * DSSM, MTOK, DSSM, DSSM, DSSM, DSSM}; pg8::StaticOrder S; S.init(MTOK, DSSM, G, bx); EpiGlu E{YACT, YMIX, SSQB}; pg8::gemm_phase(lds, g, S, E); }
#endif
        PHASE_END
        PHASE_BEGIN
#if !defined(ONLY) || ONLY == 8
        { pg8::Gemm g{YMIX, WOUT + (size_t)l * DM * DM, MTOK, DM, DM, DM, DM}; pg8::StaticOrder S; S.init(MTOK, DM, G, bx);
          EpiRes<false, false> E{H, nullptr, nullptr, STB + (size_t)(2 * l) * MTOK * 2, l ? in[29] + (l - 1) * DM : in[2], l ? in[30] + (l - 1) * DM : in[3], (i64*)(STB + (size_t)(2 * l + 1) * MTOK * 2), SSQB}; pg8::gemm_phase(lds, g, S, E); }
#endif
        PHASE_END
        PHASE_BEGIN
#if !defined(ONLY) || ONLY == 10
        for (size_t i = gt; i < (size_t)MTOK; i += NGT) SSQB[i] = 0;
        { int lp_ = lane; asm volatile("" : "+v"(lp_));
        for (int m0 = gw; m0 < MTOK; m0 += 2 * NGW) { f32x4 pv[2];
#pragma unroll
            for (int j = 0; j < 2; ++j) { const int m = m0 + j * NGW; if (m < MTOK) pv[j] = *((const f32x4*)(in[1] + ((size_t)l * MTOK + m) * PLE) + lp_); }
#pragma unroll
            for (int j = 0; j < 2; ++j) { const int m = m0 + j * NGW; if (m < MTOK) { u32x2 w; w.x = cvt_pk_bf16(pv[j][0], pv[j][1]); w.y = cvt_pk_bf16(pv[j][2], pv[j][3]); *((u32x2*)(GB + (size_t)m * GPP) + lp_) = w; } } } asm volatile("" ::: "memory"); }
        { pg8::Gemm g{H, WPG + (size_t)l * DM * DM, MTOK, DM, DM, DM, DM}; pg8::StaticOrder S; S.init(MTOK, DM, G, bx); EpiGate E{GT, in[28] + l * DM, STB + (size_t)(2 * l + 1) * MTOK * 2, CSV + l * CS_L + CSO_PG, CSV + l * CS_L + BWO_PG}; pg8::gemm_phase(lds, g, S, E); }
        { pg8::Gemm g{H, WGU + (size_t)l * 2 * DFF * DM, MTOK, 2 * DFF, DM, DM, DM}; pg8::StaticOrder S; S.init(MTOK, 2 * DFF, G, bx); EpiGU E{GB, STB + (size_t)(2 * l + 1) * MTOK * 2, CSV + l * CS_L + CSO_GU, CSV + l * CS_L + BWO_GU}; pg8::gemm_phase(lds, g, S, E);
        }
#endif
        PHASE_END
        PHASE_BEGIN
#if !defined(ONLY) || ONLY == 11
        { pg8::Gemm g{GB, WD + (size_t)l * DM * GPP, MTOK, DM, GPP, GPP, GPP}; pg8::StaticOrder S; S.init(MTOK, DM, G, bx);
          EpiRes<true, false> E{H, GT, nullptr, STB + (size_t)(2 * l + 1) * MTOK * 2, in[21] + l * DM, in[22] + l * DM, (i64*)(STB + (size_t)(2 * l + 2) * MTOK * 2), nullptr}; pg8::gemm_phase(lds, g, S, E); }
#endif
        PHASE_END
    }
    PHASE_BEGIN
#if !defined(ONLY) || ONLY == 12
    {
        const i64* STL = STB + (size_t)(2 * DEPTH) * MTOK * 2; const float* g2 = in[29] + (DEPTH - 1) * DM; const float* b2 = in[30] + (DEPTH - 1) * DM;
        for (int m = gw; m < MTOK; m += NGW) { const RowStat rs = row_stat(STL, m);
#pragma unroll
            for (int j = 0; j < 4; ++j) { const u32x2 hh = ((const u32x2*)(H + (size_t)m * DM))[lane + 64 * j]; const f32x4 gg = ((const f32x4*)g2)[lane + 64 * j], bb = ((const f32x4*)b2)[lane + 64 * j];
                f32x4 o = {bf_lo(hh.x), bf_hi(hh.x), bf_lo(hh.y), bf_hi(hh.y)}; o = (o - rs.mu) * rs.rs * gg + bb; ((f32x4*)(X + (size_t)m * DM))[lane + 64 * j] = o; } }
    }
#endif
    PHASE_END
#ifdef EXTRA_SYNCS
    if (hi - lo > 1) for (int i = 0; i < EXTRA_SYNCS; ++i) grid.sync();
#endif
#undef PHASE_BEGIN
#undef PHASE_END
}

constexpr int N_PHASES = 2 + 8 * DEPTH + 1;

extern "C" void kernel_launch(void* const* d_in, const int* in_sizes, int n_in, void* d_out, int out_size, void* d_ws, size_t ws_size, hipStream_t stream) {
    static int grid = 0;
    if (grid == 0) {
        if (n_in != 31 || out_size != MTOK * DM || ws_size < WS_END) { fprintf(stderr, "kernel_launch: unexpected shapes (n_in %d out %d ws %zu)\n", n_in, out_size, ws_size); grid = -1; return; }
        int dev = 0, cus = 0, per_cu = 0;
        hipGetDevice(&dev); hipDeviceGetAttribute(&cus, hipDeviceAttributeMultiprocessorCount, dev);
        if (hipFuncSetAttribute((const void*)mega_fwd, hipFuncAttributeMaxDynamicSharedMemorySize, LDS_BYTES) != hipSuccess) { fprintf(stderr, "kernel_launch: hipFuncSetAttribute failed\n"); }
        if (hipOccupancyMaxActiveBlocksPerMultiprocessor(&per_cu, (const void*)mega_fwd, NTHR, LDS_BYTES) != hipSuccess || per_cu < 1) { fprintf(stderr, "kernel_launch: occupancy query says %d\n", per_cu); per_cu = 1; }
        (void)hipGetLastError();
        grid = cus * per_cu;
    }
    if (grid < 0) return;
    if (hipMemsetAsync((unsigned char*)d_ws + WS_CTL, 0, CTL_BYTES, stream) != hipSuccess) fprintf(stderr, "kernel_launch: memset failed\n");
    Args a{};
    for (int i = 0; i < 31; ++i) a.in[i] = (const float*)d_in[i];
    a.out = (float*)d_out; a.ws = (unsigned char*)d_ws;
#if MK_SPLIT
    for (int p = 0; p < N_PHASES; ++p) { a.lo = p; a.hi = p + 1; hipLaunchKernelGGL(mega_fwd, dim3(grid), dim3(NTHR), LDS_BYTES, stream, a); }
#else
    a.lo = 0; a.hi = N_PHASES;
    void* kargs[] = {&a};
    hipError_t e = hipLaunchCooperativeKernel((const void*)mega_fwd, dim3(grid), dim3(NTHR), kargs, LDS_BYTES, stream);
    if (e != hipSuccess) fprintf(stderr, "kernel_launch: cooperative launch failed: %s (grid %d)\n", hipGetErrorString(e), grid);
#endif
}
```

```cpp
#include <hip/hip_runtime.h>
#include <hip/hip_cooperative_groups.h>
#include <cstdio>
#include <cstdint>
namespace cg = cooperative_groups;


#ifndef DOUBLE_MASK
#define DOUBLE_MASK 0
#endif
#ifndef MK_SPLIT
#define MK_SPLIT 0
#endif

namespace pg8 {
#define PG8_LAS __attribute__((address_space(3)))
typedef unsigned short bf16_t;
typedef short bf16x8 __attribute__((ext_vector_type(8)));
typedef float f32x4 __attribute__((ext_vector_type(4)));
typedef unsigned u32x4 __attribute__((ext_vector_type(4)));
typedef unsigned u32x2 __attribute__((ext_vector_type(2)));
constexpr int BM = 256, BK = 64, HALF = 128, HTB = HALF * BK * 2, STAGE_BYTES = 8 * HTB, NXCD = 8, WGM = 4;

__host__ __device__ __forceinline__ int lds_byte(int r, int c) { const int st = (r >> 4) * 2 + (c >> 5), rr = r & 15, cc = c & 31, ob = rr * 64 + cc * 2; return st * 1024 + (ob ^ (((ob >> 9) & 1) << 5)); }
__host__ __device__ __forceinline__ void stage_rc(int b, int& R, int& C) { const int st = b / 1024, sb = b % 1024, swz = sb ^ (((sb >> 9) & 1) << 5); R = (st >> 1) * 16 + swz / 64; C = (st & 1) * 32 + (swz % 64) / 2; }
__host__ __device__ __forceinline__ int perm32(int rho) { const int n = rho >> 4, i = rho & 15; return 8 * (i >> 2) + 4 * n + (i & 3); }

struct Unit { int pm, pn; };
struct Gemm { const bf16_t* A; const bf16_t* Bt; int M, N, K, lda, ldb; };

struct StaticOrder {
    int nM, nN, nwg, G, c;
    __host__ __device__ void init(int M, int N, int G_, int c_) { nM = M / BM; nN = N / BM; nwg = nM * nN; G = G_; c = c_; }
    __host__ __device__ bool next(int i, Unit& u) const {
        const long L = (long)i * G + c; if (L >= nwg) return false;
        int wgid = (int)L; { const int q = nwg / NXCD, r = nwg % NXCD, xcd = wgid % NXCD, off = wgid / NXCD; wgid = (xcd < r ? xcd * (q + 1) : r * (q + 1) + (xcd - r) * q) + off; }
        const int nig = WGM * nN, gid = wgid / nig, fm = gid * WGM, gsz = (nM - fm) < WGM ? (nM - fm) : WGM;
        u.pm = fm + ((wgid % nig) % gsz); u.pn = (wgid % nig) / gsz; return true;
    }
};
struct OneUnit { Unit u; __device__ bool next(int i, Unit& o) const { if (i) return false; o = u; return true; } };

typedef float f32x2_t __attribute__((ext_vector_type(2)));
typedef __bf16 bf16x2_t __attribute__((ext_vector_type(2)));
__device__ __forceinline__ unsigned cvt_pk_bf16(float lo, float hi) { f32x2_t v = {lo, hi}; bf16x2_t b = __builtin_convertvector(v, bf16x2_t); return __builtin_bit_cast(unsigned, b); }

template <class Epi, class Sched>
__device__ __forceinline__ void gemm_phase(PG8_LAS unsigned char* lds, const Gemm g, const Sched& S, const Epi& E) {
    int tid_ = threadIdx.x; asm volatile("" : "+v"(tid_));
    const int tid = tid_, wid = __builtin_amdgcn_readfirstlane(tid >> 6), lane = tid & 63, wr = wid >> 2, wc = wid & 3, fr = lane & 15, fq = lane >> 4;
    const int K = g.K, nt = K / BK;
    unsigned voffA[2], voffB[2];
#pragma unroll
    for (int i = 0; i < 2; ++i) { int R, C; stage_rc(tid * 16 + i * 8192, R, C); const int Rb = Epi::PERM ? ((R & ~31) + perm32(R & 31)) : R;
        voffA[i] = (unsigned)(R * g.lda + C) * 2u; voffB[i] = (unsigned)(Rb * g.ldb + C) * 2u; }
    const size_t kstep = (size_t)(BK * 2);
    const size_t hA = (size_t)HALF * g.lda * 2, hB = (size_t)HALF * g.ldb * 2;
    const size_t tA = 2 * hA, tB = 2 * hB;
    const unsigned ldsw = (unsigned)wid * 1024u;
    const int aoff = lds_byte(wr * 64 + fr, fq * 8), boff = lds_byte(wc * 32 + fr, fq * 8);
#define PG8_SA(b, h) (((b) * 2 + (h)) * HTB)
#define PG8_SB(b, h) ((4 + (b) * 2 + (h)) * HTB)
#define PG8_STAGE(bufoff, gbase, voff) do { _Pragma("unroll") for (int _i = 0; _i < 2; ++_i) \
        __builtin_amdgcn_global_load_lds((const unsigned*)((const char*)(gbase) + (voff)[_i]), (PG8_LAS unsigned*)(lds + (bufoff) + ldsw + _i * 8192), 16, 0, 0); } while (0)
#define PG8_LDA(dst, b, h) do { _Pragma("unroll") for (int m = 0; m < 4; ++m) _Pragma("unroll") for (int k = 0; k < 2; ++k) dst[m][k] = *(const PG8_LAS bf16x8*)(lds + PG8_SA(b, h) + aoff + m * 2048 + k * 1024); } while (0)
#define PG8_LDB(dst, b, h) do { _Pragma("unroll") for (int n = 0; n < 2; ++n) _Pragma("unroll") for (int k = 0; k < 2; ++k) dst[n][k] = *(const PG8_LAS bf16x8*)(lds + PG8_SB(b, h) + boff + n * 2048 + k * 1024); } while (0)
#define PG8_MMA(ai, bj, At, Bt) do { __builtin_amdgcn_s_setprio(1); _Pragma("unroll") for (int m = 0; m < 4; ++m) _Pragma("unroll") for (int n = 0; n < 2; ++n) _Pragma("unroll") for (int k = 0; k < 2; ++k) \
        acc[ai][bj][m][n] = __builtin_amdgcn_mfma_f32_16x16x32_bf16(Bt[n][k], At[m][k], acc[ai][bj][m][n], 0, 0, 0); __builtin_amdgcn_s_setprio(0); } while (0)
#define PG8_WAIT_V(n) asm volatile("s_waitcnt vmcnt(" #n ")" ::: "memory")
#define PG8_WAIT_L(n) asm volatile("s_waitcnt lgkmcnt(" #n ")" ::: "memory")
#define PG8_BAR __builtin_amdgcn_s_barrier()
#define PG8_SCHED __builtin_amdgcn_sched_barrier(0)
    Unit cur, nxt; int ui = 0;
    if (!S.next(0, cur)) return;
    f32x4 acc[2][2][4][2];
#pragma unroll
    for (int a = 0; a < 2; ++a)
#pragma unroll
        for (int b = 0; b < 2; ++b)
#pragma unroll
            for (int m = 0; m < 4; ++m)
#pragma unroll
                for (int n = 0; n < 2; ++n) acc[a][b][m][n] = (f32x4){0.f, 0.f, 0.f, 0.f};
    bf16x8 At[4][2], B0[2][2], B1[2][2];
    const char* cA = (const char*)g.A + (size_t)cur.pm * tA; const char* cB = (const char*)g.Bt + (size_t)cur.pn * tB;
    PG8_STAGE(PG8_SB(0, 0), cB, voffB); PG8_STAGE(PG8_SB(0, 1), cB + hB, voffB); PG8_STAGE(PG8_SA(0, 0), cA, voffA); PG8_STAGE(PG8_SA(0, 1), cA + hA, voffA);
    if (wr == 1) PG8_BAR;
    PG8_WAIT_V(2); PG8_BAR;
    PG8_STAGE(PG8_SB(1, 0), cB + kstep, voffB); PG8_STAGE(PG8_SA(1, 0), cA + kstep, voffA); PG8_STAGE(PG8_SB(1, 1), cB + hB + kstep, voffB);
    PG8_WAIT_V(6); PG8_BAR;
    for (;;) {
        const bool has_next = S.next(ui + 1, nxt);
        const char* nA = has_next ? (const char*)g.A + (size_t)nxt.pm * tA : cA; const char* nB = has_next ? (const char*)g.Bt + (size_t)nxt.pn * tB : cB;
#pragma unroll 1
        for (int t = 0; t < nt; t += 2) {
            if constexpr (Epi::MID_T >= 0) { if (t == Epi::MID_T) E.mid(acc, cur, wr, wc, fr, fq); }
            const bool last = (t == nt - 2);
            const char* a1 = cA + (size_t)(t + 1) * kstep;
            const char* a2 = last ? nA : cA + (size_t)(t + 2) * kstep; const char* b2 = last ? nB : cB + (size_t)(t + 2) * kstep;
            const char* a3 = a2 + kstep; const char* b3 = b2 + kstep;
            PG8_LDB(B0, 0, 0); PG8_LDB(B1, 0, 1); PG8_SCHED; PG8_LDA(At, 0, 0); PG8_STAGE(PG8_SA(1, 1), a1 + hA, voffA);
            PG8_WAIT_V(8); PG8_WAIT_L(0); PG8_BAR; PG8_MMA(0, 0, At, B0); PG8_MMA(0, 1, At, B1); PG8_BAR; PG8_SCHED;
            PG8_LDA(At, 0, 1); PG8_STAGE(PG8_SB(0, 0), b2, voffB); PG8_STAGE(PG8_SB(0, 1), b2 + hB, voffB); PG8_STAGE(PG8_SA(0, 0), a2, voffA);
            PG8_WAIT_V(8); PG8_WAIT_L(0); PG8_BAR; PG8_MMA(1, 0, At, B0); PG8_MMA(1, 1, At, B1); PG8_BAR; PG8_SCHED;
            PG8_LDB(B0, 1, 0); PG8_LDB(B1, 1, 1); PG8_SCHED; PG8_LDA(At, 1, 0); PG8_STAGE(PG8_SA(0, 1), a2 + hA, voffA);
            PG8_WAIT_V(8); PG8_WAIT_L(0); PG8_BAR; PG8_MMA(0, 0, At, B0); PG8_MMA(0, 1, At, B1); PG8_BAR; PG8_SCHED;
            PG8_LDA(At, 1, 1); PG8_STAGE(PG8_SB(1, 0), b3, voffB); PG8_STAGE(PG8_SB(1, 1), b3 + hB, voffB); PG8_STAGE(PG8_SA(1, 0), a3, voffA);
            PG8_WAIT_V(8); PG8_WAIT_L(0); PG8_BAR; PG8_MMA(1, 0, At, B0); PG8_MMA(1, 1, At, B1); PG8_BAR; PG8_SCHED;
        }
        if (wr == 0) PG8_BAR;
        E(acc, cur, wr, wc, fr, fq);
        if (!has_next) break;
#pragma unroll
        for (int a = 0; a < 2; ++a)
#pragma unroll
            for (int b = 0; b < 2; ++b)
#pragma unroll
                for (int m = 0; m < 4; ++m)
#pragma unroll
                    for (int n = 0; n < 2; ++n) acc[a][b][m][n] = (f32x4){0.f, 0.f, 0.f, 0.f};
        cur = nxt; cA = nA; cB = nB; ++ui;
        if (wr == 1) PG8_BAR;
    }
    PG8_WAIT_V(0);
    PG8_BAR;
#undef PG8_SA
#undef PG8_SB
#undef PG8_STAGE
#undef PG8_LDA
#undef PG8_LDB
#undef PG8_MMA
#undef PG8_WAIT_V
#undef PG8_WAIT_L
#undef PG8_BAR
#undef PG8_SCHED
}
}

using pg8::bf16_t; using pg8::f32x4; using pg8::u32x4; using pg8::u32x2; using pg8::bf16x8; using pg8::Unit; using pg8::cvt_pk_bf16;
#define LAS __attribute__((address_space(3)))

constexpr int DM = 1024, BATCH = 8, SEQ = 4096, DEPTH = 4, MTOK = BATCH * SEQ;
constexpr int DSSM = 512, NG = 32, GH = 16, NP = 64, DSGU = 512, NHEAD = 8, SBLK = 128, DIN = 1536, DFF = 2816, PLE = 256;
constexpr int TC = 32;
constexpr int NROW = MTOK / TC;
constexpr int NCH = SEQ / TC;
constexpr int UAP = TC * GH + 2 * NP;
constexpr float ALPHA = 1.681792830507429f;
constexpr float LN_EPS = 1e-5f;
constexpr int NWAVES = 8, NTHR = 512;
constexpr int LDS_BYTES = 147456 + 64, LDS_MISC = 147456;

constexpr size_t MiB = 1u << 20;
constexpr size_t WS_WIN = 0, WS_WGLU = 12 * MiB, WS_WOUT = 14 * MiB, WS_WGU = 22 * MiB, WS_WD = 66 * MiB, WS_WPLE = 88 * MiB, WS_WPG = 90 * MiB, WS_WSGU = 98 * MiB;
constexpr size_t WS_E = 99 * MiB, WS_BBAR = 102 * MiB, WS_KS = 103 * MiB;
constexpr size_t WS_KM = 108 * MiB, WS_PT = 128 * MiB, WS_PBF = 136 * MiB, WS_H = 152 * MiB;
constexpr size_t WS_R = 216 * MiB;
constexpr int GPP = PLE + DFF;
constexpr size_t WS_G = WS_R, WS_GT = WS_R + 192 * MiB;
constexpr size_t WS_UA = WS_R, WS_US = WS_R + 40 * MiB, WS_VT = WS_R + 72 * MiB, WS_SLOC = WS_R + 104 * MiB, WS_YMIX = WS_R + 120 * MiB;
constexpr size_t WS_CTL = WS_R + 256 * MiB, CTL_BYTES = 6 * MiB;
constexpr size_t WS_CSI = WS_CTL + 65536;
constexpr size_t WS_ST = WS_CTL + MiB;
constexpr size_t WS_SSQ = WS_CTL + 5 * MiB + 512 * 1024;
constexpr size_t WS_CS = WS_CTL + 6 * MiB;
constexpr size_t WS_END = WS_CTL + 7 * MiB;
constexpr int CSO_IN = 0, BWO_IN = 1536, CSO_PG = 3072, BWO_PG = 4096, CSO_GU = 5120, BWO_GU = 10752, CS_L = 16384;

constexpr int N_PHASES_C = 2 + 8 * 4 + 1;
struct Args { const float* in[31]; float* out; unsigned char* ws; int lo, hi; };

__device__ __forceinline__ float bf_lo(unsigned w) { return __uint_as_float(w << 16); }
__device__ __forceinline__ float bf_hi(unsigned w) { return __uint_as_float(w & 0xffff0000u); }
__device__ __forceinline__ float sigm(float x) { return __builtin_amdgcn_rcpf(1.f + __builtin_amdgcn_exp2f(-1.4426950408889634f * x)); }
__device__ __forceinline__ float gelu_t(float x) { const float u = x * (1.f + 0.044715f * x * x); return x * __builtin_amdgcn_rcpf(1.f + __builtin_amdgcn_exp2f(-2.3022081985f * u)); }
__device__ __forceinline__ float wave_sum(float v) {
#pragma unroll
    for (int o = 1; o < 64; o <<= 1) v += __shfl_xor(v, o);
    return v;
}
__device__ __forceinline__ u32x4 pack8(const f32x4& a, const f32x4& b) { u32x4 w; w.x = cvt_pk_bf16(a[0], a[1]); w.y = cvt_pk_bf16(a[2], a[3]); w.z = cvt_pk_bf16(b[0], b[1]); w.w = cvt_pk_bf16(b[2], b[3]); return w; }

struct RowStat { float mu, rs; };
typedef long long i64;
__device__ __forceinline__ RowStat row_stat(const i64* ST, int r) { const i64 ta = ST[2 * r], tq = ST[2 * r + 1]; const float mu = (float)ta * (1.f / (1024.f * 16777216.f)); const float var = fmaxf((float)tq * (1.f / (1024.f * 16777216.f)) - mu * mu, 0.f); RowStat o; o.mu = mu; o.rs = 1.f / sqrtf(var + LN_EPS); return o; }
__device__ __forceinline__ void row_stats8(const i64* ST, int row0, RowStat (&rs)[8]) {
    i64 ta[8], tq[8];
#pragma unroll
    for (int i = 0; i < 8; ++i) { const int r = row0 + (i >> 2) * 128 + (i & 3) * 16; ta[i] = ST[2 * r]; tq[i] = ST[2 * r + 1]; }
#pragma unroll
    for (int i = 0; i < 8; ++i) { const float mu = (float)ta[i] * (1.f / (1024.f * 16777216.f)); const float var = fmaxf((float)tq[i] * (1.f / (1024.f * 16777216.f)) - mu * mu, 0.f); rs[i].mu = mu; rs[i].rs = 1.f / sqrtf(var + LN_EPS); }
}
__device__ __forceinline__ LAS float* red_ptr() { extern __shared__ __attribute__((aligned(16))) unsigned char lds_raw[]; return (LAS float*)((LAS unsigned char*)lds_raw + 131072); }
__device__ __forceinline__ void wg_reduce_rows(LAS float* RED, const float (&a)[8], const float (&q)[8], int wr, int wc, int fr, int fq, float& oa, float& oq) {
#pragma unroll
    for (int i = 0; i < 8; ++i) { float x = a[i], y = q[i]; x += __shfl_xor(x, 16); x += __shfl_xor(x, 32); y += __shfl_xor(y, 16); y += __shfl_xor(y, 32);
        if (fq == 0) { const int rl = (i >> 2) * 128 + wr * 64 + (i & 3) * 16 + fr; RED[(rl * 4 + wc) * 2] = x; RED[(rl * 4 + wc) * 2 + 1] = y; } }
    asm volatile("s_waitcnt lgkmcnt(0)" ::: "memory"); __builtin_amdgcn_s_barrier(); asm volatile("" ::: "memory");
    const int t = (wr * 4 + wc) * 64 + fq * 16 + fr; oa = 0.f; oq = 0.f;
    if (t < 256) { const f32x4 u = *(LAS f32x4*)(RED + t * 8), v = *(LAS f32x4*)(RED + t * 8 + 4); oa = (u[0] + u[2]) + (v[0] + v[2]); oq = (u[1] + u[3]) + (v[1] + v[3]); }
    asm volatile("s_waitcnt lgkmcnt(0)" ::: "memory"); __builtin_amdgcn_s_barrier(); asm volatile("" ::: "memory");
}
typedef const f32x4 (&AccRef)[2][2][4][2];
struct EpiWin { static constexpr bool PERM = true; static constexpr int MID_T = -1;
    bf16_t* UA; bf16_t* US; const i64* ST; const float* cs; const float* bw;
    __device__ __forceinline__ void operator()(AccRef acc, const Unit& u, int wr, int wc, int fr, int fq) const {
        const int row0 = u.pm * 256 + wr * 64 + fr, col0 = u.pn * 256 + wc * 32 + 8 * fq;
        RowStat rs8[8]; row_stats8(ST, row0, rs8);
#pragma unroll
        for (int bj = 0; bj < 2; ++bj) { const int c = col0 + bj * 128;
            const f32x4 c0 = *(const f32x4*)(cs + c), c1 = *(const f32x4*)(cs + c + 4), b0 = *(const f32x4*)(bw + c), b1 = *(const f32x4*)(bw + c + 4);
#pragma unroll
            for (int ai = 0; ai < 2; ++ai)
#pragma unroll
                for (int m = 0; m < 4; ++m) { const int r = row0 + ai * 128 + m * 16; const RowStat rs = rs8[ai * 4 + m];
                    f32x4 v0 = (acc[ai][bj][m][0] - c0 * rs.mu) * rs.rs + b0, v1 = (acc[ai][bj][m][1] - c1 * rs.mu) * rs.rs + b1;
                    if (u.pn < 2) { *(u32x4*)(UA + ((size_t)(c >> 4) * NROW + (r >> 5)) * UAP + (r & 31) * 16 + (c & 15)) = pack8(v0, v1); }
                    else {
#pragma unroll
                        for (int j = 0; j < 4; ++j) { v0[j] = gelu_t(v0[j]); v1[j] = gelu_t(v1[j]); }
                        *(u32x4*)(US + (size_t)r * DSGU + (c - 512)) = pack8(v0, v1); }
                    asm volatile("" ::: "memory"); } }
    }
};
struct EpiVT { static constexpr bool PERM = true; static constexpr int MID_T = -1;
    bf16_t* VT; const i64* ST; const float* cs; const float* bw;
    __device__ __forceinline__ void operator()(AccRef acc, const Unit& u, int wr, int wc, int fr, int fq) const {
        const int row0 = u.pm * 256 + wr * 64 + fr, col0 = u.pn * 256 + wc * 32 + 8 * fq;
#pragma unroll
        for (int bj = 0; bj < 2; ++bj) { const int c = col0 + bj * 128; float mu[8], rsd[8];
#pragma unroll
            for (int j = 0; j < 8; ++j) { const RowStat t = row_stat(ST, c + j); mu[j] = t.mu; rsd[j] = t.rs; }
#pragma unroll
            for (int ai = 0; ai < 2; ++ai)
#pragma unroll
                for (int m = 0; m < 4; ++m) { const int r = row0 + ai * 128 + m * 16; const float cc = cs[r], bb = bw[r]; f32x4 v0, v1;
#pragma unroll
                    for (int j = 0; j < 4; ++j) { v0[j] = gelu_t((acc[ai][bj][m][0][j] - cc * mu[j]) * rsd[j] + bb); v1[j] = gelu_t((acc[ai][bj][m][1][j] - cc * mu[4 + j]) * rsd[4 + j] + bb); }
                    *(u32x4*)(VT + ((size_t)(c >> 7) * 512 + r) * 128 + (c & 127)) = pack8(v0, v1);
                    asm volatile("" ::: "memory"); } }
    }
};
struct EpiGate { static constexpr bool PERM = true; static constexpr int MID_T = -1;
    bf16_t* GT; const float* bias; const i64* ST; const float* cs; const float* bw;
    __device__ __forceinline__ void operator()(AccRef acc, const Unit& u, int wr, int wc, int fr, int fq) const {
        const int row0 = u.pm * 256 + wr * 64 + fr, col0 = u.pn * 256 + wc * 32 + 8 * fq;
        RowStat rs8[8]; row_stats8(ST, row0, rs8);
#pragma unroll
        for (int bj = 0; bj < 2; ++bj) { const int c = col0 + bj * 128;
            const f32x4 c0 = *(const f32x4*)(cs + c), c1 = *(const f32x4*)(cs + c + 4);
            const f32x4 b0 = *(const f32x4*)(bw + c) + *(const f32x4*)(bias + c), b1 = *(const f32x4*)(bw + c + 4) + *(const f32x4*)(bias + c + 4);
#pragma unroll
            for (int ai = 0; ai < 2; ++ai)
#pragma unroll
                for (int m = 0; m < 4; ++m) { const int r = row0 + ai * 128 + m * 16; const RowStat rs = rs8[ai * 4 + m];
                    f32x4 v0 = (acc[ai][bj][m][0] - c0 * rs.mu) * rs.rs + b0, v1 = (acc[ai][bj][m][1] - c1 * rs.mu) * rs.rs + b1;
#pragma unroll
                    for (int j = 0; j < 4; ++j) { v0[j] = sigm(v0[j]); v1[j] = sigm(v1[j]); }
                    *(u32x4*)(GT + (size_t)r * DM + c) = pack8(v0, v1);
                    asm volatile("" ::: "memory"); } }
    }
};
template <int ACT> struct EpiBf { static constexpr bool PERM = true; static constexpr int MID_T = -1;
    bf16_t* O; int ldc; const float* bias;
    __device__ __forceinline__ void operator()(AccRef acc, const Unit& u, int wr, int wc, int fr, int fq) const {
        const int row0 = u.pm * 256 + wr * 64 + fr, col0 = u.pn * 256 + wc * 32 + 8 * fq;
        f32x4 bv[2][2];
#pragma unroll
        for (int bj = 0; bj < 2; ++bj)
#pragma unroll
            for (int n = 0; n < 2; ++n) bv[bj][n] = (ACT == 2) ? *(const f32x4*)(bias + col0 + bj * 128 + 4 * n) : (f32x4){0.f, 0.f, 0.f, 0.f};
#pragma unroll
        for (int ai = 0; ai < 2; ++ai)
#pragma unroll
            for (int m = 0; m < 4; ++m) { bf16_t* rowp = O + (size_t)(row0 + ai * 128 + m * 16) * ldc + col0;
#pragma unroll
                for (int bj = 0; bj < 2; ++bj) { f32x4 v0 = acc[ai][bj][m][0] + bv[bj][0], v1 = acc[ai][bj][m][1] + bv[bj][1];
#pragma unroll
                    for (int j = 0; j < 4; ++j) { if (ACT == 1) { v0[j] = gelu_t(v0[j]); v1[j] = gelu_t(v1[j]); } if (ACT == 2) { v0[j] = sigm(v0[j]); v1[j] = sigm(v1[j]); } }
                    *(u32x4*)(rowp + bj * 128) = pack8(v0, v1); }
                asm volatile("" ::: "memory"); }
    }
};
struct EpiSloc { static constexpr bool PERM = false; static constexpr int MID_T = -1;
    float* SL;
    __device__ __forceinline__ void operator()(AccRef acc, const Unit& u, int wr, int wc, int fr, int fq) const {
        const int row0 = u.pm * 256 + wr * 64 + fr, col0 = wc * 32 + 4 * fq;
#pragma unroll
        for (int ai = 0; ai < 2; ++ai)
#pragma unroll
            for (int m = 0; m < 4; ++m) { float* rowp = SL + (size_t)(row0 + ai * 128 + m * 16) * 128 + col0;
#pragma unroll
                for (int n = 0; n < 2; ++n) *(f32x4*)(rowp + n * 16) = acc[ai][0][m][n]; }
    }
};
struct EpiY { static constexpr bool PERM = true; static constexpr int MID_T = -1;
    bf16_t* YA; int g;
    __device__ __forceinline__ void operator()(AccRef acc, const Unit& u, int wr, int wc, int fr, int fq) const {
        const int row0 = u.pm * 256 + wr * 64 + fr, col0 = u.pn * 256 + wc * 32 + 8 * fq;
#pragma unroll
        for (int ai = 0; ai < 2; ++ai)
#pragma unroll
            for (int m = 0; m < 4; ++m) { const int R = row0 + ai * 128 + m * 16;
#pragma unroll
                for (int bj = 0; bj < 2; ++bj) { const int n = col0 + bj * 128; f32x4 v0 = acc[ai][bj][m][0], v1 = acc[ai][bj][m][1];
#pragma unroll
                    for (int j = 0; j < 4; ++j) { v0[j] = gelu_t(v0[j]); v1[j] = gelu_t(v1[j]); }
                    *(u32x4*)(YA + (size_t)(R * TC + (n >> 4)) * DSSM + g * 16 + (n & 15)) = pack8(v0, v1); }
                asm volatile("" ::: "memory"); }
    }
};
struct EpiGlu { static constexpr bool PERM = true; static constexpr int MID_T = -1;
    const bf16_t* YA; bf16_t* YM; i64* SSQ;
    __device__ __forceinline__ void operator()(AccRef acc, const Unit& u, int wr, int wc, int fr, int fq) const {
        const int row0 = u.pm * 256 + wr * 64 + fr, col0 = u.pn * 256 + wc * 32 + 8 * fq;
        float qq[8], zz[8];
#pragma unroll
        for (int i = 0; i < 8; ++i) { qq[i] = 0.f; zz[i] = 0.f; }
#pragma unroll
        for (int ai = 0; ai < 2; ++ai)
#pragma unroll
            for (int m = 0; m < 4; ++m) { const int r = row0 + ai * 128 + m * 16; const size_t off = (size_t)r * DSSM + col0; float q = 0.f;
#pragma unroll
                for (int bj = 0; bj < 2; ++bj) { const u32x4 y = *(const u32x4*)(YA + off + bj * 128); f32x4 v0 = acc[ai][bj][m][0], v1 = acc[ai][bj][m][1];
                    v0[0] = bf_lo(y.x) * sigm(v0[0]); v0[1] = bf_hi(y.x) * sigm(v0[1]); v0[2] = bf_lo(y.y) * sigm(v0[2]); v0[3] = bf_hi(y.y) * sigm(v0[3]);
                    v1[0] = bf_lo(y.z) * sigm(v1[0]); v1[1] = bf_hi(y.z) * sigm(v1[1]); v1[2] = bf_lo(y.w) * sigm(v1[2]); v1[3] = bf_hi(y.w) * sigm(v1[3]);
                    q += ((v0[0] * v0[0] + v0[1] * v0[1]) + (v0[2] * v0[2] + v0[3] * v0[3])) + ((v1[0] * v1[0] + v1[1] * v1[1]) + (v1[2] * v1[2] + v1[3] * v1[3]));
                    *(u32x4*)(YM + (size_t)r * DM + col0 + bj * 128) = pack8(v0, v1); }
                qq[ai * 4 + m] = q;
                if (m == 3) asm volatile("" ::: "memory"); }
        float oa, oq; wg_reduce_rows(red_ptr(), zz, qq, wr, wc, fr, fq, oa, oq);
        const int t = (wr * 4 + wc) * 64 + fq * 16 + fr; if (t < 256) (void)__hip_atomic_fetch_add(SSQ + u.pm * 256 + t, (i64)(oq * 16777216.f), __ATOMIC_RELAXED, __HIP_MEMORY_SCOPE_AGENT);
    }
};
template <bool HAS_PLE, bool OUT_F32> struct EpiRes { static constexpr bool PERM = true; static constexpr int MID_T = HAS_PLE ? 4 : 8;
    __device__ __forceinline__ void mid(f32x4 (&acc)[2][2][4][2], const Unit& u, int wr, int wc, int fr, int fq) const {
        asm volatile("" : "+v"(fr), "+v"(fq));
        const int row0 = u.pm * 256 + wr * 64 + fr, col0 = u.pn * 256 + wc * 32 + 8 * fq;
        if constexpr (!HAS_PLE) {
#pragma unroll
            for (int ai = 0; ai < 2; ++ai)
#pragma unroll
                for (int m = 0; m < 4; ++m) { const float sc = 1.f / sqrtf((float)SSQ[row0 + ai * 128 + m * 16] * (1.f / (512.f * 16777216.f)) + LN_EPS);
#pragma unroll
                    for (int bj = 0; bj < 2; ++bj) { acc[ai][bj][m][0] = acc[ai][bj][m][0] * sc; acc[ai][bj][m][1] = acc[ai][bj][m][1] * sc; } }
            return; }
#pragma unroll
        for (int ai = 0; ai < 2; ++ai)
#pragma unroll
            for (int m = 0; m < 4; ++m)
#pragma unroll
                for (int bj = 0; bj < 2; ++bj) { const u32x4 y = *(const u32x4*)(PL + (size_t)(row0 + ai * 128 + m * 16) * DM + col0 + bj * 128);
                    acc[ai][bj][m][0][0] *= bf_lo(y.x); acc[ai][bj][m][0][1] *= bf_hi(y.x); acc[ai][bj][m][0][2] *= bf_lo(y.y); acc[ai][bj][m][0][3] *= bf_hi(y.y);
                    acc[ai][bj][m][1][0] *= bf_lo(y.z); acc[ai][bj][m][1][1] *= bf_hi(y.z); acc[ai][bj][m][1][2] *= bf_lo(y.w); acc[ai][bj][m][1][3] *= bf_hi(y.w);
                    if (bj == 1 && (m & 1)) asm volatile("" ::: "memory"); }
    }
    bf16_t* Hh; const bf16_t* PL; float* Xf; const i64* STin; const float* gin; const float* bin; i64* STout; const i64* SSQ;
    __device__ __forceinline__ void operator()(AccRef acc, const Unit& u, int wr, int wc, int fr, int fq) const {
        const int row0 = u.pm * 256 + wr * 64 + fr, col0 = u.pn * 256 + wc * 32 + 8 * fq;
        float ssum[8], ssq[8];
#pragma unroll
        for (int i = 0; i < 8; ++i) { ssum[i] = 0.f; ssq[i] = 0.f; }
        RowStat rs8[8]; row_stats8(STin, row0, rs8);
#pragma unroll
        for (int bj = 0; bj < 2; ++bj) { const int c = col0 + bj * 128;
            const f32x4 g0 = *(const f32x4*)(gin + c), g1 = *(const f32x4*)(gin + c + 4), b0 = *(const f32x4*)(bin + c), b1 = *(const f32x4*)(bin + c + 4);
#pragma unroll
            for (int ai = 0; ai < 2; ++ai)
#pragma unroll
                for (int m = 0; m < 4; ++m) { const int r = row0 + ai * 128 + m * 16; const size_t o = (size_t)r * DM + c; const RowStat rs = rs8[ai * 4 + m];
                    const u32x4 hh = *(const u32x4*)(Hh + o);
                    f32x4 h0 = {bf_lo(hh.x), bf_hi(hh.x), bf_lo(hh.y), bf_hi(hh.y)}, h1 = {bf_lo(hh.z), bf_hi(hh.z), bf_lo(hh.w), bf_hi(hh.w)};
                    h0 = (h0 - rs.mu) * rs.rs * g0 + b0; h1 = (h1 - rs.mu) * rs.rs * g1 + b1;
                    f32x4 v0 = h0 * ALPHA + acc[ai][bj][m][0], v1 = h1 * ALPHA + acc[ai][bj][m][1];
                    if (OUT_F32) { *(f32x4*)(Xf + o) = v0; *(f32x4*)(Xf + o + 4) = v1; }
                    else { *(u32x4*)(Hh + o) = pack8(v0, v1);
                        ssum[ai * 4 + m] += ((v0[0] + v0[1]) + (v0[2] + v0[3])) + ((v1[0] + v1[1]) + (v1[2] + v1[3]));
                        ssq[ai * 4 + m] += ((v0[0] * v0[0] + v0[1] * v0[1]) + (v0[2] * v0[2] + v0[3] * v0[3])) + ((v1[0] * v1[0] + v1[1] * v1[1]) + (v1[2] * v1[2] + v1[3] * v1[3])); }
                    if (m == 3 && ai == 1) asm volatile("" ::: "memory"); } }
        if (!OUT_F32) { float oa, oq; wg_reduce_rows(red_ptr(), ssum, ssq, wr, wc, fr, fq, oa, oq);
            const int t = (wr * 4 + wc) * 64 + fq * 16 + fr;
            if (t < 256) { const int r = u.pm * 256 + t; (void)__hip_atomic_fetch_add(STout + 2 * r, (i64)(oa * 16777216.f), __ATOMIC_RELAXED, __HIP_MEMORY_SCOPE_AGENT); (void)__hip_atomic_fetch_add(STout + 2 * r + 1, (i64)(oq * 16777216.f), __ATOMIC_RELAXED, __HIP_MEMORY_SCOPE_AGENT); } }
    }
};
struct EpiPle { static constexpr bool PERM = true; static constexpr int MID_T = -1;
    bf16_t* GT;
    __device__ __forceinline__ void operator()(AccRef acc, const Unit& u, int wr, int wc, int fr, int fq) const {
        const int row0 = u.pm * 256 + wr * 64 + fr, col0 = u.pn * 256 + wc * 32 + 8 * fq;
#pragma unroll
        for (int ai = 0; ai < 2; ++ai)
#pragma unroll
            for (int m = 0; m < 4; ++m) { const size_t off = (size_t)(row0 + ai * 128 + m * 16) * DM + col0;
#pragma unroll
                for (int bj = 0; bj < 2; ++bj) { const u32x4 y = *(const u32x4*)(GT + off + bj * 128); f32x4 v0 = acc[ai][bj][m][0], v1 = acc[ai][bj][m][1];
                    v0[0] *= bf_lo(y.x); v0[1] *= bf_hi(y.x); v0[2] *= bf_lo(y.y); v0[3] *= bf_hi(y.y);
                    v1[0] *= bf_lo(y.z); v1[1] *= bf_hi(y.z); v1[2] *= bf_lo(y.w); v1[3] *= bf_hi(y.w);
                    *(u32x4*)(GT + off + bj * 128) = pack8(v0, v1); }
                asm volatile("" ::: "memory"); }
    }
};
struct EpiGU { static constexpr bool PERM = true; static constexpr int MID_T = -1;
    bf16_t* G; const i64* ST; const float* cs; const float* bw;
    __device__ __forceinline__ void operator()(AccRef acc, const Unit& u, int wr, int wc, int fr, int fq) const {
        const int row0 = u.pm * 256 + wr * 64 + fr, col0 = u.pn * 128 + wc * 32 + 8 * fq, cg = u.pn * 256 + wc * 32 + 8 * fq;
        const f32x4 cg0 = *(const f32x4*)(cs + cg), cg1 = *(const f32x4*)(cs + cg + 4), bg0 = *(const f32x4*)(bw + cg), bg1 = *(const f32x4*)(bw + cg + 4);
        const f32x4 cu0 = *(const f32x4*)(cs + cg + 128), cu1 = *(const f32x4*)(cs + cg + 132), bu0 = *(const f32x4*)(bw + cg + 128), bu1 = *(const f32x4*)(bw + cg + 132);
        RowStat rs8[8]; row_stats8(ST, row0, rs8);
#pragma unroll
        for (int ai = 0; ai < 2; ++ai)
#pragma unroll
            for (int m = 0; m < 4; ++m) { const int r = row0 + ai * 128 + m * 16; const RowStat rs = rs8[ai * 4 + m];
                const f32x4 ga = (acc[ai][0][m][0] - cg0 * rs.mu) * rs.rs + bg0, gb = (acc[ai][0][m][1] - cg1 * rs.mu) * rs.rs + bg1;
                const f32x4 ua = (acc[ai][1][m][0] - cu0 * rs.mu) * rs.rs + bu0, ub = (acc[ai][1][m][1] - cu1 * rs.mu) * rs.rs + bu1;
                f32x4 v0, v1;
#pragma unroll
                for (int j = 0; j < 4; ++j) { v0[j] = ga[j] * sigm(ga[j]) * ua[j]; v1[j] = gb[j] * sigm(gb[j]) * ub[j]; }
                __builtin_nontemporal_store(pack8(v0, v1), (u32x4*)(G + (size_t)r * GPP + PLE + col0));
                asm volatile("" ::: "memory"); }
    }
};

__device__ __forceinline__ unsigned f2bf(float f) { unsigned u = __builtin_bit_cast(unsigned, f); return (u + 0x7fffu + ((u >> 16) & 1u)) >> 16; }
__device__ __forceinline__ unsigned pk2(float lo, float hi) { return f2bf(lo) | (f2bf(hi) << 16); }
__device__ __forceinline__ void transpose_item(const float* W, int K, int N, bf16_t* WT, int k0, int n0, int dst_row0, LAS float* scr, int lane, const float* gk = nullptr, const float* bk = nullptr, i64* cs = nullptr, i64* bw = nullptr, int ldw = 0, int koff = 0) {
    if (ldw == 0) ldw = K;
#pragma unroll 8
    for (int i = 0; i < 32; ++i) { const int kk = 2 * i + (lane >> 5); scr[kk * 33 + (lane & 31)] = W[(size_t)(k0 + kk) * N + n0 + (lane & 31)]; }
    asm volatile("s_waitcnt lgkmcnt(0)" ::: "memory");
    const int c = lane & 7;
    float gs[8];
#pragma unroll
    for (int i = 0; i < 8; ++i) gs[i] = gk ? gk[k0 + 8 * c + i] : 1.f;
    if (gk && cs) { const int n = lane & 31; const float* vv = (lane < 32) ? gk : bk; float a = 0.f;
#pragma unroll 8
        for (int kk = 0; kk < 64; ++kk) a += scr[kk * 33 + n] * vv[k0 + kk];
        (void)__hip_atomic_fetch_add(((lane < 32) ? cs : bw) + dst_row0 + n, (i64)(a * 4294967296.f), __ATOMIC_RELAXED, __HIP_MEMORY_SCOPE_AGENT); }
#pragma unroll
    for (int j = 0; j < 4; ++j) { const int n = (lane >> 3) + 8 * j; const LAS float* sp = scr + (8 * c) * 33 + n;
        u32x4 o; o.x = pk2(sp[0 * 33] * gs[0], sp[1 * 33] * gs[1]); o.y = pk2(sp[2 * 33] * gs[2], sp[3 * 33] * gs[3]); o.z = pk2(sp[4 * 33] * gs[4], sp[5 * 33] * gs[5]); o.w = pk2(sp[6 * 33] * gs[6], sp[7 * 33] * gs[7]);
        *(u32x4*)(WT + (size_t)(dst_row0 + n) * ldw + koff + k0 + 8 * c) = o; }
    asm volatile("s_waitcnt lgkmcnt(0)" ::: "memory");
}
__device__ __forceinline__ void raw_row(const float* xrow, bf16_t* brow, i64* st, int lane) {
    const f32x4* xr = (const f32x4*)xrow + lane; float a = 0.f, q = 0.f;
#pragma unroll
    for (int j = 0; j < 4; ++j) { const f32x4 v = __builtin_nontemporal_load(xr + 64 * j); a += (v[0] + v[1]) + (v[2] + v[3]); q += (v[0] * v[0] + v[1] * v[1]) + (v[2] * v[2] + v[3] * v[3]);
        u32x2 w; w.x = cvt_pk_bf16(v[0], v[1]); w.y = cvt_pk_bf16(v[2], v[3]); ((u32x2*)brow)[lane + 64 * j] = w; }
    a = wave_sum(a); q = wave_sum(q);
    if (lane == 0) { st[0] = (i64)(a * 16777216.f); st[1] = (i64)(q * 16777216.f); }
}
template <bool WF32, bool WBF>
__device__ __forceinline__ void ln_row(const float* xrow, const float* g, const float* b, float* frow, bf16_t* brow, int lane) {
    const f32x4* xr = (const f32x4*)xrow + lane;
    f32x4 v[4]; float s = 0.f;
#pragma unroll
    for (int j = 0; j < 4; ++j) { v[j] = xr[64 * j]; s += (v[j][0] + v[j][1]) + (v[j][2] + v[j][3]); }
    const float mean = wave_sum(s) * (1.f / DM); float s2 = 0.f;
#pragma unroll
    for (int j = 0; j < 4; ++j) { v[j] = v[j] - mean; s2 += (v[j][0] * v[j][0] + v[j][1] * v[j][1]) + (v[j][2] * v[j][2] + v[j][3] * v[j][3]); }
    const float rstd = 1.f / sqrtf(wave_sum(s2) * (1.f / DM) + LN_EPS);
#pragma unroll
    for (int j = 0; j < 4; ++j) { const f32x4 gg = ((const f32x4*)g)[lane + 64 * j], bb = ((const f32x4*)b)[lane + 64 * j]; const f32x4 o = v[j] * rstd * gg + bb;
        if (WF32) ((f32x4*)frow)[lane + 64 * j] = o; if (WBF) { u32x2 w; w.x = cvt_pk_bf16(o[0], o[1]); w.y = cvt_pk_bf16(o[2], o[3]); ((u32x2*)brow)[lane + 64 * j] = w; } }
}


#define XB_TMO      128
#define XB_XCNT(j)  (256  + 64 * (j))
#define XB_XSUB(j)  (1280 + 64 * (j))
#define XB_XGEN(j)  (2304 + 64 * (j))
#define XB_TOP      3328
#define XB_TOPGEN   3392
#define XCD_BAR_WORDS 3456
#define XB_SPIN_CAP (1u << 20)
__device__ __forceinline__ unsigned xb_ld(unsigned* p)              { return __hip_atomic_load(p, __ATOMIC_RELAXED, __HIP_MEMORY_SCOPE_AGENT); }
__device__ __forceinline__ unsigned xb_add(unsigned* p, unsigned v) { return __hip_atomic_fetch_add(p, v, __ATOMIC_RELAXED, __HIP_MEMORY_SCOPE_AGENT); }
__device__ __forceinline__ unsigned xb_xcc_id() { return (unsigned)__builtin_amdgcn_s_getreg((3 << 11) | 20) & 0xFu; }
#define XB_SPIN(cond, bar) do { unsigned _sp = 0; while (cond) { __builtin_amdgcn_s_sleep(1); \
    if ((++_sp & 255u) == 0u) { if (xb_ld(&(bar)[XB_TMO])) break; if (_sp > XB_SPIN_CAP) { atomicAdd(&(bar)[XB_TMO], 1u); break; } } } } while (0)
struct XcdBarrier { unsigned* bar; unsigned x; volatile LAS unsigned* st; };
__device__ __forceinline__ XcdBarrier xcd_barrier_post(unsigned* bar, volatile LAS unsigned* st) {
    XcdBarrier b; b.bar = bar; b.x = xb_xcc_id(); b.st = st;
    if (threadIdx.x == 0) (void)xb_add(&bar[XB_XCNT(b.x)], 1u);
    return b;
}
__device__ __forceinline__ void xcd_barrier_complete(unsigned* bar, unsigned x, unsigned& nloc, unsigned& nx) {
    const unsigned G = gridDim.x * gridDim.y * gridDim.z;
    unsigned sum, cnt, mine, sp = 0u;
    for (;;) {
        sum = 0u; cnt = 0u; mine = 0u;
#pragma unroll
        for (unsigned j = 0; j < 16; ++j) { const unsigned c = xb_ld(&bar[XB_XCNT(j)]); sum += c; cnt += (c > 0u) ? 1u : 0u; mine = (j == x) ? c : mine; }
        if (sum == G) break;
        __builtin_amdgcn_s_sleep(1);
        if ((++sp & 255u) == 0u) { if (xb_ld(&bar[XB_TMO])) break; if (sp > XB_SPIN_CAP) { atomicAdd(&bar[XB_TMO], 1u); break; } }
    }
    nloc = mine > 0u ? mine : 1u; nx = cnt > 0u ? cnt : 1u;
}
__device__ __forceinline__ void xcd_barrier(const XcdBarrier& b) {
    asm volatile("s_waitcnt vmcnt(0)" ::: "memory");
    __syncthreads();
    if (threadIdx.x == 0) {
        unsigned* bar = b.bar;
        __builtin_amdgcn_s_waitcnt(0);
        unsigned nloc = b.st[0], nx = b.st[1];
        if (nloc == 0u) { xcd_barrier_complete(bar, b.x, nloc, nx); b.st[0] = nloc; b.st[1] = nx; }
        const unsigned old = xb_add(&bar[XB_XSUB(b.x)], 1u);
        const unsigned gen = old / nloc;
        if (old + 1u == (gen + 1u) * nloc) {
            __builtin_amdgcn_fence(__ATOMIC_RELEASE, "agent");
            asm volatile("s_waitcnt vmcnt(0)" ::: "memory");
            const unsigned og = xb_add(&bar[XB_TOP], 1u);
            const unsigned tg = og / nx;
            if (og + 1u == (tg + 1u) * nx) xb_add(&bar[XB_TOPGEN], 1u);
            else XB_SPIN(xb_ld(&bar[XB_TOPGEN]) == tg, bar);
            __builtin_amdgcn_fence(__ATOMIC_ACQUIRE, "agent");
            xb_add(&bar[XB_XGEN(b.x)], 1u);
            asm volatile("s_waitcnt vmcnt(0)" ::: "memory");
        } else {
            XB_SPIN(xb_ld(&bar[XB_XGEN(b.x)]) == gen, bar);
            __builtin_amdgcn_fence(__ATOMIC_ACQUIRE, "agent");
            asm volatile("s_waitcnt vmcnt(0)" ::: "memory");
        }
    }
    __syncthreads();
}

__global__ void __launch_bounds__(NTHR, 2) mega_fwd(Args args) {
    extern __shared__ __attribute__((aligned(16))) unsigned char lds_raw[];
    LAS unsigned char* lds = (LAS unsigned char*)lds_raw;
    cg::grid_group grid = cg::this_grid();
    const int tid0 = threadIdx.x, wave = __builtin_amdgcn_readfirstlane(tid0 >> 6);
    const int G = gridDim.x, bx = blockIdx.x;
    const int gw = bx * NWAVES + wave, NGW = G * NWAVES;
    const size_t NGT = (size_t)G * NTHR;
    unsigned char* ws = args.ws;
    const float* const* in = args.in;
    float* X = args.out;
    bf16_t* H = (bf16_t*)(ws + WS_H);
    bf16_t* WIN = (bf16_t*)(ws + WS_WIN); bf16_t* WGLU = (bf16_t*)(ws + WS_WGLU); bf16_t* WOUT = (bf16_t*)(ws + WS_WOUT); bf16_t* WGU = (bf16_t*)(ws + WS_WGU);
    bf16_t* WD = (bf16_t*)(ws + WS_WD); bf16_t* WPG = (bf16_t*)(ws + WS_WPG); bf16_t* WSGU = (bf16_t*)(ws + WS_WSGU);
    float2* ET = (float2*)(ws + WS_E); float2* BBAR = (float2*)(ws + WS_BBAR); float* KS = (float*)(ws + WS_KS);
    bf16_t* KM = (bf16_t*)(ws + WS_KM); bf16_t* PT = (bf16_t*)(ws + WS_PT);
    bf16_t* GB = (bf16_t*)(ws + WS_G); bf16_t* GT = (bf16_t*)(ws + WS_GT);
    bf16_t* UA = (bf16_t*)(ws + WS_UA); bf16_t* US = (bf16_t*)(ws + WS_US); bf16_t* VT = (bf16_t*)(ws + WS_VT); float* SLOC = (float*)(ws + WS_SLOC); bf16_t* YMIX = (bf16_t*)(ws + WS_YMIX);
    bf16_t* YGLU = US; bf16_t* YACT = VT;
    float* CSV = (float*)(ws + WS_CS); i64* CSI = (i64*)(ws + WS_CSI); i64* STB = (i64*)(ws + WS_ST); i64* SSQB = (i64*)(ws + WS_SSQ);
    const int lo = args.lo, hi = args.hi;
    int ph = 0;
    volatile LAS unsigned* MISC = (volatile LAS unsigned*)(lds + LDS_MISC);
    if (tid0 < 16) MISC[tid0] = 0u;
    __syncthreads();
    XcdBarrier xbar; xbar.bar = (unsigned*)(ws + WS_CTL); xbar.x = 0; xbar.st = MISC;
    if (hi - lo > 1) xbar = xcd_barrier_post((unsigned*)(ws + WS_CTL), MISC);
#define PHASE_BEGIN if (lo <= ph && ph < hi) { const int kind_ = ph < 2 ? ph : (ph == N_PHASES_C - 1 ? 11 : 2 + (ph - 2) % 8); const int nrep_ = ((DOUBLE_MASK >> kind_) & 1) ? 2 : 1; for (int rep_ = 0; rep_ < nrep_; ++rep_) { int tid = tid0; asm volatile("" : "+v"(tid)); const int lane = tid & 63; const size_t gt = (size_t)bx * NTHR + tid; (void)lane; (void)gt;
#define PHASE_END   } if (ph + 1 < hi) { if (ph == 0) grid.sync(); else xcd_barrier(xbar); } } ++ph;

    PHASE_BEGIN
#if !defined(ONLY) || ONLY == 0
    {
        LAS float* scr = (LAS float*)(lds + wave * 16384);
        constexpr int I_IN = 16 * 48, I_GLU = 8 * 16, I_OUT = 16 * 32, I_GA = 16 * 88, I_DN = 44 * 32, I_PLE = 4 * 32, I_PG = 16 * 32;
        constexpr int I_L = I_IN + I_GLU + I_OUT + 2 * I_GA + I_DN + I_PLE + I_PG;
        for (int it = gw; it < DEPTH * I_L; it += NGW) {
            const int l = it / I_L; int r = it % I_L;
            if (r < I_IN) { const int nb = r % 48, kb = r / 48; transpose_item(in[4] + (size_t)l * DM * DIN, DM, DIN, WIN + (size_t)l * DIN * DM, 64 * kb, 32 * nb, 32 * nb, scr, lane, l ? in[29] + (l - 1) * DM : in[2], l ? in[30] + (l - 1) * DM : in[3], CSI + l * CS_L + CSO_IN, CSI + l * CS_L + BWO_IN); continue; } r -= I_IN;
            if (r < I_GLU) { const int nb = r % 16, kb = r / 16; transpose_item(in[13] + (size_t)l * DSSM * DSSM, DSSM, DSSM, WGLU + (size_t)l * DSSM * DSSM, 64 * kb, 32 * nb, 32 * nb, scr, lane); continue; } r -= I_GLU;
            if (r < I_OUT) { const int nb = r % 32, kb = r / 32; transpose_item(in[20] + (size_t)l * DM * DM, DM, DM, WOUT + (size_t)l * DM * DM, 64 * kb, 32 * nb, 32 * nb, scr, lane, kb < 8 ? in[18] + l * DSSM : nullptr); continue; } r -= I_OUT;
            if (r < I_GA) { const int nb = r % 88, kb = r / 88, n0 = 32 * nb; transpose_item(in[23] + (size_t)l * DM * DFF, DM, DFF, WGU + (size_t)l * 2 * DFF * DM, 64 * kb, n0, 256 * (n0 / 128) + (n0 % 128), scr, lane, in[21] + l * DM, in[22] + l * DM, CSI + l * CS_L + CSO_GU, CSI + l * CS_L + BWO_GU); continue; } r -= I_GA;
            if (r < I_GA) { const int nb = r % 88, kb = r / 88, n0 = 32 * nb; transpose_item(in[24] + (size_t)l * DM * DFF, DM, DFF, WGU + (size_t)l * 2 * DFF * DM, 64 * kb, n0, 256 * (n0 / 128) + 128 + (n0 % 128), scr, lane, in[21] + l * DM, in[22] + l * DM, CSI + l * CS_L + CSO_GU, CSI + l * CS_L + BWO_GU); continue; } r -= I_GA;
            if (r < I_DN) { const int nb = r % 32, kb = r / 32; transpose_item(in[25] + (size_t)l * DFF * DM, DFF, DM, WD + (size_t)l * DM * GPP, 64 * kb, 32 * nb, 32 * nb, scr, lane, nullptr, nullptr, nullptr, nullptr, GPP, PLE); continue; } r -= I_DN;
            if (r < I_PLE) { const int nb = r % 32, kb = r / 32; transpose_item(in[26] + (size_t)l * PLE * DM, PLE, DM, WD + (size_t)l * DM * GPP, 64 * kb, 32 * nb, 32 * nb, scr, lane, nullptr, nullptr, nullptr, nullptr, GPP, 0); continue; } r -= I_PLE;
            { const int nb = r % 32, kb = r / 32; transpose_item(in[27] + (size_t)l * DM * DM, DM, DM, WPG + (size_t)l * DM * DM, 64 * kb, 32 * nb, 32 * nb, scr, lane, in[21] + l * DM, in[22] + l * DM, CSI + l * CS_L + CSO_PG, CSI + l * CS_L + BWO_PG); }
        }
        for (int m = gw; m < MTOK; m += NGW) raw_row(in[0] + (size_t)m * DM, H + (size_t)m * DM, STB + 2 * (size_t)m, lane);
        for (size_t i = gt; i < (size_t)DEPTH * NG * NP; i += NGT) {
            const int lg = (int)(i / NP);
            const double dt = exp((double)in[7][lg]);
            const double are = in[5][i], aim = in[6][i];
            const double mag = exp(are * dt), abr = mag * cos(aim * dt), abi = mag * sin(aim * dt);
            const double nr = abr - 1.0, ni = abi, den = are * are + aim * aim;
            const double cr = (nr * are + ni * aim) / den, ci = (ni * are - nr * aim) / den;
            double er = 1.0, ei = 0.0;
            for (int k = 0; k <= TC; ++k) { ET[i * (TC + 1) + k] = make_float2((float)er, (float)ei); const double t = er * abr - ei * abi; ei = er * abi + ei * abr; er = t; }
            for (int h = 0; h < GH; ++h) { const double br = in[8][i * GH + h], bi = in[9][i * GH + h]; BBAR[i * GH + h] = make_float2((float)(cr * br - ci * bi), (float)(cr * bi + ci * br)); }
        }
        for (size_t i = gt; i < (size_t)DEPTH * NHEAD * SBLK * SBLK; i += NGT) { const int jj = (int)(i & 127), ii = (int)((i >> 7) & 127); WSGU[i] = (bf16_t)(((ii >> 6) >= (jj >> 6)) ? f2bf(in[16][i]) : 0u); }
    }
#endif
    PHASE_END
    PHASE_BEGIN
#if !defined(ONLY) || ONLY == 1
    for (size_t i = gt; i < (size_t)DEPTH * CS_L; i += NGT) CSV[i] = (float)((double)CSI[i] * (1.0 / 4294967296.0));
    for (size_t i4 = gt; i4 < (size_t)DEPTH * NG * TC * GH * GH / 4; i4 += NGT) {
        const size_t i = i4 * 4; const int hi0 = (int)(i & 15), ho = (int)((i >> 4) & 15), k = (int)((i >> 8) & 31), lg = (int)(i >> 13);
        const float* cre = in[10] + ((size_t)lg * GH + ho) * NP; const float* cim = in[11] + ((size_t)lg * GH + ho) * NP;
        f32x4 s = {0.f, 0.f, 0.f, 0.f};
#pragma unroll 8
        for (int p = 0; p < NP; ++p) { const float2 e = ET[((size_t)lg * NP + p) * (TC + 1) + k]; const float cr = cre[p], ci = cim[p];
            const float wr_ = cr * e.x - ci * e.y, wi_ = cr * e.y + ci * e.x;
            const f32x4 b01 = *(const f32x4*)(BBAR + ((size_t)lg * NP + p) * GH + hi0), b23 = *(const f32x4*)(BBAR + ((size_t)lg * NP + p) * GH + hi0 + 2);
            s[0] += wr_ * b01[0] - wi_ * b01[1]; s[1] += wr_ * b01[2] - wi_ * b01[3]; s[2] += wr_ * b23[0] - wi_ * b23[1]; s[3] += wr_ * b23[2] - wi_ * b23[3]; }
        if (k == 0 && ho >= hi0 && ho < hi0 + 4) s[ho - hi0] += in[12][lg * GH + ho];
        *(f32x4*)(KS + i) = s;
    }
#endif
    PHASE_END

    for (int l = 0; l < DEPTH; ++l) {
        PHASE_BEGIN
#if !defined(ONLY) || ONLY == 2
        {
            for (size_t e = gt; e < (size_t)NG * 512 * (UAP / 8); e += NGT) {
                const int k8 = (int)(e % (UAP / 8)), n = (int)((e / (UAP / 8)) % 512), g = (int)(e / ((UAP / 8) * 512));
                const int i = n >> 4, ho = n & 15, lg = l * NG + g; float v[8];
                if (k8 < 64) { const int j = k8 >> 1, h0 = (k8 & 1) * 8;
                    if (i >= j) { const float* src = KS + ((((size_t)lg * TC + (i - j)) * GH + ho) * GH + h0);
                        const f32x4 s0 = *(const f32x4*)src, s1 = *(const f32x4*)(src + 4);
#pragma unroll
                        for (int q = 0; q < 4; ++q) { v[q] = s0[q]; v[4 + q] = s1[q]; } }
                    else {
#pragma unroll
                        for (int q = 0; q < 8; ++q) v[q] = 0.f; } }
                else { const int q0 = (k8 - 64) * 8, part = q0 >> 6, p0 = q0 & 63;
                    const float* crp = in[10] + ((size_t)lg * GH + ho) * NP + p0; const float* cip = in[11] + ((size_t)lg * GH + ho) * NP + p0;
                    const f32x4 cr0 = *(const f32x4*)crp, cr1 = *(const f32x4*)(crp + 4), ci0 = *(const f32x4*)cip, ci1 = *(const f32x4*)(cip + 4);
#pragma unroll
                    for (int q = 0; q < 8; ++q) { const int p = p0 + q; const float2 a = ET[((size_t)lg * NP + p) * (TC + 1) + (i + 1)];
                        const float cr = q < 4 ? cr0[q & 3] : cr1[q & 3], ci = q < 4 ? ci0[q & 3] : ci1[q & 3];
                        v[q] = part ? -(cr * a.y + ci * a.x) : (cr * a.x - ci * a.y); } }
                u32x4 w; w.x = pk2(v[0], v[1]); w.y = pk2(v[2], v[3]); w.z = pk2(v[4], v[5]); w.w = pk2(v[6], v[7]);
                *(u32x4*)(KM + ((size_t)g * 512 + n) * UAP + k8 * 8) = w;
            }
            for (size_t e = gt; e < (size_t)NG * 256 * 64; e += NGT) {
                const int k8 = (int)(e & 63), n = (int)((e >> 6) & 255), g = (int)(e >> 14), lg = l * NG + g; float v[8];
                if (n < 128) { const int part = n >> 6, p = n & 63, j = k8 >> 1, h0 = (k8 & 1) * 8; const float2 a = ET[((size_t)lg * NP + p) * (TC + 1) + (TC - 1 - j)];
                    const f32x4* bp = (const f32x4*)(BBAR + ((size_t)lg * NP + p) * GH + h0);
#pragma unroll
                    for (int q2 = 0; q2 < 4; ++q2) { const f32x4 b = bp[q2];
                        v[2 * q2] = part ? (a.x * b[1] + a.y * b[0]) : (a.x * b[0] - a.y * b[1]); v[2 * q2 + 1] = part ? (a.x * b[3] + a.y * b[2]) : (a.x * b[2] - a.y * b[3]); } }
                else {
#pragma unroll
                    for (int q = 0; q < 8; ++q) v[q] = 0.f; }
                u32x4 w; w.x = pk2(v[0], v[1]); w.y = pk2(v[2], v[3]); w.z = pk2(v[4], v[5]); w.w = pk2(v[6], v[7]);
                *(u32x4*)(PT + ((size_t)g * 256 + n) * 512 + k8 * 8) = w;
            }
            { pg8::Gemm g{H, WIN + (size_t)l * DIN * DM, MTOK, 1024, DM, DM, DM}; pg8::StaticOrder S; S.init(MTOK, 1024, G, bx); EpiWin E{UA, US, STB + (size_t)(2 * l) * MTOK * 2, CSV + l * CS_L + CSO_IN, CSV + l * CS_L + BWO_IN}; pg8::gemm_phase(lds, g, S, E); }
            { pg8::Gemm g{WIN + (size_t)l * DIN * DM + (size_t)1024 * DM, H, 512, MTOK, DM, DM, DM}; pg8::StaticOrder S; S.init(512, MTOK, G, bx); EpiVT E{VT, STB + (size_t)(2 * l) * MTOK * 2, CSV + l * CS_L + CSO_IN + 1024, CSV + l * CS_L + BWO_IN + 1024}; pg8::gemm_phase(lds, g, S, E); }
        }
#endif
        PHASE_END
        PHASE_BEGIN
#if !defined(ONLY) || ONLY == 3
        {
            const bf16_t* Wl = WSGU + (size_t)l * NHEAD * SBLK * SBLK;
            const float* lng = in[14] + l * DSGU; const float* lnb = in[15] + l * DSGU; const float* bs = in[17] + l * NHEAD * SBLK; const float* gsg = in[19] + l * DSGU;
            LAS float* ST = (LAS float*)(lds + 139264);
            for (int blk = bx; blk < MTOK / SBLK; blk += G) {
                const int tok0 = blk * SBLK;
                int tst_ = tid; asm volatile("" : "+v"(tst_));
#pragma unroll
                for (int hb = 0; hb < 2; ++hb) { u32x4 stg[8];
#pragma unroll
                    for (int j = 0; j < 8; ++j) { const int idx = tst_ + (hb * 8 + j) * NTHR, ch = idx >> 4, seg = idx & 15; stg[j] = *(const u32x4*)(VT + ((size_t)blk * 512 + ch) * 128 + seg * 8); }
#pragma unroll
                    for (int j = 0; j < 8; ++j) { const int idx = tst_ + (hb * 8 + j) * NTHR, ch = idx >> 4, seg = idx & 15; *(LAS u32x4*)(lds + ch * 272 + seg * 16) = stg[j]; } }
                __syncthreads();
                {
                    float s0 = 0.f, s1 = 0.f, q0 = 0.f, q1 = 0.f;
#pragma unroll 16
                    for (int cc = 0; cc < 64; ++cc) { const unsigned w = *(LAS unsigned*)(lds + (wave * 64 + cc) * 272 + lane * 4); const float a = bf_lo(w), b = bf_hi(w); s0 += a; q0 += a * a; s1 += b; q1 += b * b; }
                    ST[(wave * 64 + lane) * 4 + 0] = s0; ST[(wave * 64 + lane) * 4 + 1] = q0; ST[(wave * 64 + lane) * 4 + 2] = s1; ST[(wave * 64 + lane) * 4 + 3] = q1;
                    __syncthreads();
                    s0 = s1 = q0 = q1 = 0.f;
#pragma unroll
                    for (int o = 0; o < 8; ++o) { const f32x4 t = *(LAS f32x4*)(ST + (o * 64 + lane) * 4); s0 += t[0]; q0 += t[1]; s1 += t[2]; q1 += t[3]; }
                    const float m0 = s0 * (1.f / 512.f), m1 = s1 * (1.f / 512.f);
                    const float r0 = 1.f / sqrtf(fmaxf(q0 * (1.f / 512.f) - m0 * m0, 0.f) + LN_EPS), r1 = 1.f / sqrtf(fmaxf(q1 * (1.f / 512.f) - m1 * m1, 0.f) + LN_EPS);
                    const float gl = lng[wave * 64 + lane], bl = lnb[wave * 64 + lane];
#pragma unroll 8
                    for (int cc = 0; cc < 64; ++cc) { const int ch = wave * 64 + cc; LAS unsigned* pw = (LAS unsigned*)(lds + ch * 272 + lane * 4); const unsigned w = *pw;
                        const float gg = __builtin_bit_cast(float, __builtin_amdgcn_readlane(__builtin_bit_cast(int, gl), cc)), bb = __builtin_bit_cast(float, __builtin_amdgcn_readlane(__builtin_bit_cast(int, bl), cc));
                        *pw = cvt_pk_bf16((bf_lo(w) - m0) * r0 * gg + bb, (bf_hi(w) - m1) * r1 * gg + bb); }
                    __syncthreads();
                }
                {
                    const int fr = lane & 15, fq = lane >> 4, h = wave;
                    f32x4 acc[8][4];
#pragma unroll
                    for (int mt = 0; mt < 8; ++mt)
#pragma unroll
                        for (int nt = 0; nt < 4; ++nt) acc[mt][nt] = (f32x4){0.f, 0.f, 0.f, 0.f};
                    const bf16_t* Wh = Wl + (size_t)h * SBLK * SBLK;
                    bf16x8 afr[8];
#pragma unroll
                    for (int mt = 0; mt < 8; ++mt) afr[mt] = *(const bf16x8*)(Wh + (size_t)(mt * 16 + fr) * SBLK + fq * 8);
#pragma unroll 1
                    for (int ks = 0; ks < 4; ++ks) {
                        bf16x8 bfr[4], anx[8];
#pragma unroll
                        for (int nt = 0; nt < 4; ++nt) bfr[nt] = *(const LAS bf16x8*)(lds + (h * 64 + nt * 16 + fr) * 272 + (ks * 32 + fq * 8) * 2);
#pragma unroll
                        for (int mt = 0; mt < 8; ++mt) anx[mt] = *(const bf16x8*)(Wh + (size_t)(mt * 16 + fr) * SBLK + ((ks + 1) & 3) * 32 + fq * 8);
#pragma unroll
                        for (int mt = 0; mt < 8; ++mt)
#pragma unroll
                            for (int nt = 0; nt < 4; ++nt) acc[mt][nt] = __builtin_amdgcn_mfma_f32_16x16x32_bf16(bfr[nt], afr[mt], acc[mt][nt], 0, 0, 0);
#pragma unroll
                        for (int mt = 0; mt < 8; ++mt) afr[mt] = anx[mt];
                    }
                    float part[8];
#pragma unroll
                    for (int mt = 0; mt < 8; ++mt) { const int i = mt * 16 + fr; const float bias = bs[h * SBLK + i]; float q = 0.f;
#pragma unroll
                        for (int nt = 0; nt < 4; ++nt) { const u32x2 uu = *(const u32x2*)(US + (size_t)(tok0 + i) * DSGU + h * 64 + nt * 16 + fq * 4); f32x4 o = acc[mt][nt] + bias;
                            o[0] *= bf_lo(uu.x); o[1] *= bf_hi(uu.x); o[2] *= bf_lo(uu.y); o[3] *= bf_hi(uu.y); acc[mt][nt] = o; q += (o[0] * o[0] + o[1] * o[1]) + (o[2] * o[2] + o[3] * o[3]); }
                        q += __shfl_xor(q, 16); q += __shfl_xor(q, 32); part[mt] = q; if ((mt & 3) == 3) asm volatile("" ::: "memory"); }
                    if (fq == 0) {
#pragma unroll
                        for (int mt = 0; mt < 8; ++mt) ST[(mt * 16 + fr) * 8 + h] = part[mt]; }
                    __syncthreads();
#pragma unroll
                    for (int mt = 0; mt < 8; ++mt) { const int i = mt * 16 + fr; const f32x4 a = *(LAS f32x4*)(ST + i * 8), b = *(LAS f32x4*)(ST + i * 8 + 4);
                        const float rs = 1.f / sqrtf(((a[0] + a[1]) + (a[2] + a[3]) + (b[0] + b[1]) + (b[2] + b[3])) * (1.f / 512.f) + LN_EPS);
#pragma unroll
                        for (int nt = 0; nt < 4; ++nt) { const int ch = h * 64 + nt * 16 + fq * 4; const f32x4 gg = *(const f32x4*)(gsg + ch); const f32x4 o = acc[mt][nt] * rs * gg;
                            u32x2 w; w.x = cvt_pk_bf16(o[0], o[1]); w.y = cvt_pk_bf16(o[2], o[3]); *(u32x2*)(YMIX + (size_t)(tok0 + i) * DM + 512 + ch) = w; } asm volatile("" ::: "memory"); }
                    __syncthreads();
                }
            }
            for (int un = bx; un < NG * 4; un += G) { const int g = un >> 2, pm = un & 3;
                pg8::Gemm gm{UA + (size_t)g * NROW * UAP, PT + (size_t)g * 256 * 512, NROW, 256, 512, UAP, 512}; pg8::OneUnit S{{pm, 0}}; EpiSloc E{SLOC + (size_t)g * NROW * 128}; pg8::gemm_phase(lds, gm, S, E); }
        }
#endif
        PHASE_END
        PHASE_BEGIN
#if !defined(ONLY) || ONLY == 4
        for (int w = bx; w < BATCH * NG; w += G) {
            const int b = w / NG, g = w % NG, lg = l * NG + g, seg = wave;
            const float2 aT = ET[((size_t)lg * NP + lane) * (TC + 1) + TC];
            const float* sl = SLOC + ((size_t)g * NROW + b * NCH + seg * 16) * 128 + lane;
            bf16_t* ua = UA + ((size_t)g * NROW + b * NCH + seg * 16) * UAP + 512 + lane;
            float lr[16], li[16];
#pragma unroll
            for (int q = 0; q < 16; ++q) { lr[q] = sl[(size_t)q * 128]; li[q] = sl[(size_t)q * 128 + 64]; }
            float sr = 0.f, si = 0.f;
#pragma unroll
            for (int q = 0; q < 16; ++q) { const float tr = aT.x * sr - aT.y * si + lr[q]; si = aT.x * si + aT.y * sr + li[q]; sr = tr; }
            LAS float* EX = (LAS float*)lds;
            EX[(seg * 64 + lane) * 2] = sr; EX[(seg * 64 + lane) * 2 + 1] = si;
            float2 a16 = aT;
#pragma unroll
            for (int q = 0; q < 4; ++q) { const float tr = a16.x * a16.x - a16.y * a16.y; a16.y = 2.f * a16.x * a16.y; a16.x = tr; }
            __syncthreads();
            sr = 0.f; si = 0.f;
            for (int v = 0; v < seg; ++v) { const float ex = EX[(v * 64 + lane) * 2], ey = EX[(v * 64 + lane) * 2 + 1]; const float tr = a16.x * sr - a16.y * si + ex; si = a16.x * si + a16.y * sr + ey; sr = tr; }
#pragma unroll
            for (int q = 0; q < 16; ++q) { ua[(size_t)q * UAP] = (bf16_t)f2bf(sr); ua[(size_t)q * UAP + 64] = (bf16_t)f2bf(si);
                const float tr = aT.x * sr - aT.y * si + lr[q]; si = aT.x * si + aT.y * sr + li[q]; sr = tr; }
            __syncthreads();
        }
#endif
        PHASE_END
        PHASE_BEGIN
#if !defined(ONLY) || ONLY == 5
        for (int un = bx; un < NG * 8; un += G) { const int g = un >> 3, pm = (un & 7) >> 1, pn = un & 1;
            pg8::Gemm gm{UA + (size_t)g * NROW * UAP, KM + (size_t)g * 512 * UAP, NROW, 512, UAP, UAP, UAP}; pg8::OneUnit S{{pm, pn}}; EpiY E{YACT, g}; pg8::gemm_phase(lds, gm, S, E); }
#endif
        PHASE_END
        PHASE_BEGIN
#if !defined(ONLY) || ONLY == 6
        { pg8::Gemm g{YACT, WGLU + (size_t)l * DSSM * DSSM, MTOK, DSSM, DSSM, DSSM, DSSM}; pg8::StaticOrder S; S.init(MTOK, DSSM, G, bx); EpiGlu E{YACT, YMIX, SSQB}; pg8::gemm_phase(lds, g, S, E); }
#endif
        PHASE_END
        PHASE_BEGIN
#if !defined(ONLY) || ONLY == 8
        { pg8::Gemm g{YMIX, WOUT + (size_t)l * DM * DM, MTOK, DM, DM, DM, DM}; pg8::StaticOrder S; S.init(MTOK, DM, G, bx);
          EpiRes<false, false> E{H, nullptr, nullptr, STB + (size_t)(2 * l) * MTOK * 2, l ? in[29] + (l - 1) * DM : in[2], l ? in[30] + (l - 1) * DM : in[3], (i64*)(STB + (size_t)(2 * l + 1) * MTOK * 2), SSQB}; pg8::gemm_phase(lds, g, S, E); }
#endif
        PHASE_END
        PHASE_BEGIN
#if !defined(ONLY) || ONLY == 10
        for (size_t i = gt; i < (size_t)MTOK; i += NGT) SSQB[i] = 0;
        { int lp_ = lane; asm volatile("" : "+v"(lp_));
        for (int m0 = gw; m0 < MTOK; m0 += 2 * NGW) { f32x4 pv[2];
#pragma unroll
            for (int j = 0; j < 2; ++j) { const int m = m0 + j * NGW; if (m < MTOK) pv[j] = __builtin_nontemporal_load((const f32x4*)(in[1] + ((size_t)l * MTOK + m) * PLE) + lp_); }
#pragma unroll
            for (int j = 0; j < 2; ++j) { const int m = m0 + j * NGW; if (m < MTOK) { u32x2 w; w.x = cvt_pk_bf16(pv[j][0], pv[j][1]); w.y = cvt_pk_bf16(pv[j][2], pv[j][3]); __builtin_nontemporal_store(w, (u32x2*)(GB + (size_t)m * GPP) + lp_); } } } asm volatile("" ::: "memory"); }
        { pg8::Gemm g{H, WPG + (size_t)l * DM * DM, MTOK, DM, DM, DM, DM}; pg8::StaticOrder S; S.init(MTOK, DM, G, bx); EpiGate E{GT, in[28] + l * DM, STB + (size_t)(2 * l + 1) * MTOK * 2, CSV + l * CS_L + CSO_PG, CSV + l * CS_L + BWO_PG}; pg8::gemm_phase(lds, g, S, E); }
        { pg8::Gemm g{H, WGU + (size_t)l * 2 * DFF * DM, MTOK, 2 * DFF, DM, DM, DM}; pg8::StaticOrder S; S.init(MTOK, 2 * DFF, G, bx); EpiGU E{GB, STB + (size_t)(2 * l + 1) * MTOK * 2, CSV + l * CS_L + CSO_GU, CSV + l * CS_L + BWO_GU}; pg8::gemm_phase(lds, g, S, E);
        }
#endif
        PHASE_END
        PHASE_BEGIN
#if !defined(ONLY) || ONLY == 11
        { pg8::Gemm g{GB, WD + (size_t)l * DM * GPP, MTOK, DM, GPP, GPP, GPP}; pg8::StaticOrder S; S.init(MTOK, DM, G, bx);
          EpiRes<true, false> E{H, GT, nullptr, STB + (size_t)(2 * l + 1) * MTOK * 2, in[21] + l * DM, in[22] + l * DM, (i64*)(STB + (size_t)(2 * l + 2) * MTOK * 2), nullptr}; pg8::gemm_phase(lds, g, S, E); }
#endif
        PHASE_END
    }
    PHASE_BEGIN
#if !defined(ONLY) || ONLY == 12
    {
        const i64* STL = STB + (size_t)(2 * DEPTH) * MTOK * 2; const float* g2 = in[29] + (DEPTH - 1) * DM; const float* b2 = in[30] + (DEPTH - 1) * DM;
        for (int m = gw; m < MTOK; m += NGW) { const RowStat rs = row_stat(STL, m);
#pragma unroll
            for (int j = 0; j < 4; ++j) { const u32x2 hh = ((const u32x2*)(H + (size_t)m * DM))[lane + 64 * j]; const f32x4 gg = ((const f32x4*)g2)[lane + 64 * j], bb = ((const f32x4*)b2)[lane + 64 * j];
                f32x4 o = {bf_lo(hh.x), bf_hi(hh.x), bf_lo(hh.y), bf_hi(hh.y)}; o = (o - rs.mu) * rs.rs * gg + bb; __builtin_nontemporal_store(o, (f32x4*)(X + (size_t)m * DM) + lane + 64 * j); } }
    }
#endif
    PHASE_END
#ifdef EXTRA_SYNCS
    if (hi - lo > 1) for (int i = 0; i < EXTRA_SYNCS; ++i) grid.sync();
#endif
#undef PHASE_BEGIN
#undef PHASE_END
}

constexpr int N_PHASES = 2 + 8 * DEPTH + 1;

extern "C" void kernel_launch(void* const* d_in, const int* in_sizes, int n_in, void* d_out, int out_size, void* d_ws, size_t ws_size, hipStream_t stream) {
    static int grid = 0;
    if (grid == 0) {
        if (n_in != 31 || out_size != MTOK * DM || ws_size < WS_END) { fprintf(stderr, "kernel_launch: unexpected shapes (n_in %d out %d ws %zu)\n", n_in, out_size, ws_size); grid = -1; return; }
        int dev = 0, cus = 0, per_cu = 0;
        hipGetDevice(&dev); hipDeviceGetAttribute(&cus, hipDeviceAttributeMultiprocessorCount, dev);
        if (hipFuncSetAttribute((const void*)mega_fwd, hipFuncAttributeMaxDynamicSharedMemorySize, LDS_BYTES) != hipSuccess) { fprintf(stderr, "kernel_launch: hipFuncSetAttribute failed\n"); }
        if (hipOccupancyMaxActiveBlocksPerMultiprocessor(&per_cu, (const void*)mega_fwd, NTHR, LDS_BYTES) != hipSuccess || per_cu < 1) { fprintf(stderr, "kernel_launch: occupancy query says %d\n", per_cu); per_cu = 1; }
        (void)hipGetLastError();
        grid = cus * per_cu;
    }
    if (grid < 0) return;
    if (hipMemsetAsync((unsigned char*)d_ws + WS_CTL, 0, CTL_BYTES, stream) != hipSuccess) fprintf(stderr, "kernel_launch: memset failed\n");
    Args a{};
    for (int i = 0; i < 31; ++i) a.in[i] = (const float*)d_in[i];
    a.out = (float*)d_out; a.ws = (unsigned char*)d_ws;
#if MK_SPLIT
    for (int p = 0; p < N_PHASES; ++p) { a.lo = p; a.hi = p + 1; hipLaunchKernelGGL(mega_fwd, dim3(grid), dim3(NTHR), LDS_BYTES, stream, a); }
#else
    a.lo = 0; a.hi = N_PHASES;
    void* kargs[] = {&a};
    hipError_t e = hipLaunchCooperativeKernel((const void*)mega_fwd, dim3(grid), dim3(NTHR), kargs, LDS_BYTES, stream);
    if (e != hipSuccess) fprintf(stderr, "kernel_launch: cooperative launch failed: %s (grid %d)\n", hipGetErrorString(e), grid);
#endif
}
```

```cpp
#include <hip/hip_runtime.h>
#include <hip/hip_cooperative_groups.h>
#include <cstdio>
#include <cstdint>
namespace cg = cooperative_groups;


#ifndef DOUBLE_MASK
#define DOUBLE_MASK 0
#endif
#ifndef MK_SPLIT
#define MK_SPLIT 0
#endif

namespace pg8 {
#define PG8_LAS __attribute__((address_space(3)))
typedef unsigned short bf16_t;
typedef short bf16x8 __attribute__((ext_vector_type(8)));
typedef float f32x4 __attribute__((ext_vector_type(4)));
typedef unsigned u32x4 __attribute__((ext_vector_type(4)));
typedef unsigned u32x2 __attribute__((ext_vector_type(2)));
constexpr int BM = 256, BK = 64, HALF = 128, HTB = HALF * BK * 2, STAGE_BYTES = 8 * HTB, NXCD = 8, WGM = 4;

__host__ __device__ __forceinline__ int lds_byte(int r, int c) { const int st = (r >> 4) * 2 + (c >> 5), rr = r & 15, cc = c & 31, ob = rr * 64 + cc * 2; return st * 1024 + (ob ^ (((ob >> 9) & 1) << 5)); }
__host__ __device__ __forceinline__ void stage_rc(int b, int& R, int& C) { const int st = b / 1024, sb = b % 1024, swz = sb ^ (((sb >> 9) & 1) << 5); R = (st >> 1) * 16 + swz / 64; C = (st & 1) * 32 + (swz % 64) / 2; }
__host__ __device__ __forceinline__ int perm32(int rho) { const int n = rho >> 4, i = rho & 15; return 8 * (i >> 2) + 4 * n + (i & 3); }

struct Unit { int pm, pn; };
struct Gemm { const bf16_t* A; const bf16_t* Bt; int M, N, K, lda, ldb; };

struct StaticOrder {
    int nM, nN, nwg, G, c;
    __host__ __device__ void init(int M, int N, int G_, int c_) { nM = M / BM; nN = N / BM; nwg = nM * nN; G = G_; c = c_; }
    __host__ __device__ bool next(int i, Unit& u) const {
        const long L = (long)i * G + c; if (L >= nwg) return false;
        int wgid = (int)L; { const int q = nwg / NXCD, r = nwg % NXCD, xcd = wgid % NXCD, off = wgid / NXCD; wgid = (xcd < r ? xcd * (q + 1) : r * (q + 1) + (xcd - r) * q) + off; }
        const int nig = WGM * nN, gid = wgid / nig, fm = gid * WGM, gsz = (nM - fm) < WGM ? (nM - fm) : WGM;
        u.pm = fm + ((wgid % nig) % gsz); u.pn = (wgid % nig) / gsz; return true;
    }
};
struct OneUnit { Unit u; __device__ bool next(int i, Unit& o) const { if (i) return false; o = u; return true; } };

typedef float f32x2_t __attribute__((ext_vector_type(2)));
typedef __bf16 bf16x2_t __attribute__((ext_vector_type(2)));
__device__ __forceinline__ unsigned cvt_pk_bf16(float lo, float hi) { f32x2_t v = {lo, hi}; bf16x2_t b = __builtin_convertvector(v, bf16x2_t); return __builtin_bit_cast(unsigned, b); }

template <class Epi, class Sched>
__device__ __forceinline__ void gemm_phase(PG8_LAS unsigned char* lds, const Gemm g, const Sched& S, const Epi& E) {
    int tid_ = threadIdx.x; asm volatile("" : "+v"(tid_));
    const int tid = tid_, wid = __builtin_amdgcn_readfirstlane(tid >> 6), lane = tid & 63, wr = wid >> 2, wc = wid & 3, fr = lane & 15, fq = lane >> 4;
    const int K = g.K, nt = K / BK;
    unsigned voffA[2], voffB[2];
#pragma unroll
    for (int i = 0; i < 2; ++i) { int R, C; stage_rc(tid * 16 + i * 8192, R, C); const int Rb = Epi::PERM ? ((R & ~31) + perm32(R & 31)) : R;
        voffA[i] = (unsigned)(R * g.lda + C) * 2u; voffB[i] = (unsigned)(Rb * g.ldb + C) * 2u; }
    const size_t kstep = (size_t)(BK * 2);
    const size_t hA = (size_t)HALF * g.lda * 2, hB = (size_t)HALF * g.ldb * 2;
    const size_t tA = 2 * hA, tB = 2 * hB;
    const unsigned ldsw = (unsigned)wid * 1024u;
    const int aoff = lds_byte(wr * 64 + fr, fq * 8), boff = lds_byte(wc * 32 + fr, fq * 8);
#define PG8_SA(b, h) (((b) * 2 + (h)) * HTB)
#define PG8_SB(b, h) ((4 + (b) * 2 + (h)) * HTB)
#define PG8_STAGE(bufoff, gbase, voff) do { _Pragma("unroll") for (int _i = 0; _i < 2; ++_i) \
        __builtin_amdgcn_global_load_lds((const unsigned*)((const char*)(gbase) + (voff)[_i]), (PG8_LAS unsigned*)(lds + (bufoff) + ldsw + _i * 8192), 16, 0, 0); } while (0)
#define PG8_LDA(dst, b, h) do { _Pragma("unroll") for (int m = 0; m < 4; ++m) _Pragma("unroll") for (int k = 0; k < 2; ++k) dst[m][k] = *(const PG8_LAS bf16x8*)(lds + PG8_SA(b, h) + aoff + m * 2048 + k * 1024); } while (0)
#define PG8_LDB(dst, b, h) do { _Pragma("unroll") for (int n = 0; n < 2; ++n) _Pragma("unroll") for (int k = 0; k < 2; ++k) dst[n][k] = *(const PG8_LAS bf16x8*)(lds + PG8_SB(b, h) + boff + n * 2048 + k * 1024); } while (0)
#define PG8_MMA(ai, bj, At, Bt) do { __builtin_amdgcn_s_setprio(1); _Pragma("unroll") for (int m = 0; m < 4; ++m) _Pragma("unroll") for (int n = 0; n < 2; ++n) _Pragma("unroll") for (int k = 0; k < 2; ++k) \
        acc[ai][bj][m][n] = __builtin_amdgcn_mfma_f32_16x16x32_bf16(Bt[n][k], At[m][k], acc[ai][bj][m][n], 0, 0, 0); __builtin_amdgcn_s_setprio(0); } while (0)
#define PG8_WAIT_V(n) asm volatile("s_waitcnt vmcnt(" #n ")" ::: "memory")
#define PG8_WAIT_L(n) asm volatile("s_waitcnt lgkmcnt(" #n ")" ::: "memory")
#define PG8_BAR __builtin_amdgcn_s_barrier()
#define PG8_SCHED __builtin_amdgcn_sched_barrier(0)
    Unit cur, nxt; int ui = 0;
    if (!S.next(0, cur)) return;
    f32x4 acc[2][2][4][2];
#pragma unroll
    for (int a = 0; a < 2; ++a)
#pragma unroll
        for (int b = 0; b < 2; ++b)
#pragma unroll
            for (int m = 0; m < 4; ++m)
#pragma unroll
                for (int n = 0; n < 2; ++n) acc[a][b][m][n] = (f32x4){0.f, 0.f, 0.f, 0.f};
    bf16x8 At[4][2], B0[2][2], B1[2][2];
    const char* cA = (const char*)g.A + (size_t)cur.pm * tA; const char* cB = (const char*)g.Bt + (size_t)cur.pn * tB;
    PG8_STAGE(PG8_SB(0, 0), cB, voffB); PG8_STAGE(PG8_SB(0, 1), cB + hB, voffB); PG8_STAGE(PG8_SA(0, 0), cA, voffA); PG8_STAGE(PG8_SA(0, 1), cA + hA, voffA);
    if (wr == 1) PG8_BAR;
    PG8_WAIT_V(2); PG8_BAR;
    PG8_STAGE(PG8_SB(1, 0), cB + kstep, voffB); PG8_STAGE(PG8_SA(1, 0), cA + kstep, voffA); PG8_STAGE(PG8_SB(1, 1), cB + hB + kstep, voffB);
    PG8_WAIT_V(6); PG8_BAR;
    for (;;) {
        const bool has_next = S.next(ui + 1, nxt);
        const char* nA = has_next ? (const char*)g.A + (size_t)nxt.pm * tA : cA; const char* nB = has_next ? (const char*)g.Bt + (size_t)nxt.pn * tB : cB;
#pragma unroll 1
        for (int t = 0; t < nt; t += 2) {
            if constexpr (Epi::MID_T >= 0) { if (t == Epi::MID_T) E.mid(acc, cur, wr, wc, fr, fq); }
            const bool last = (t == nt - 2);
            const char* a1 = cA + (size_t)(t + 1) * kstep;
            const char* a2 = last ? nA : cA + (size_t)(t + 2) * kstep; const char* b2 = last ? nB : cB + (size_t)(t + 2) * kstep;
            const char* a3 = a2 + kstep; const char* b3 = b2 + kstep;
            PG8_LDB(B0, 0, 0); PG8_LDB(B1, 0, 1); PG8_SCHED; PG8_LDA(At, 0, 0); PG8_STAGE(PG8_SA(1, 1), a1 + hA, voffA);
            PG8_WAIT_V(8); PG8_WAIT_L(0); PG8_BAR; PG8_MMA(0, 0, At, B0); PG8_MMA(0, 1, At, B1); PG8_BAR; PG8_SCHED;
            PG8_LDA(At, 0, 1); PG8_STAGE(PG8_SB(0, 0), b2, voffB); PG8_STAGE(PG8_SB(0, 1), b2 + hB, voffB); PG8_STAGE(PG8_SA(0, 0), a2, voffA);
            PG8_WAIT_V(8); PG8_WAIT_L(0); PG8_BAR; PG8_MMA(1, 0, At, B0); PG8_MMA(1, 1, At, B1); PG8_BAR; PG8_SCHED;
            PG8_LDB(B0, 1, 0); PG8_LDB(B1, 1, 1); PG8_SCHED; PG8_LDA(At, 1, 0); PG8_STAGE(PG8_SA(0, 1), a2 + hA, voffA);
            PG8_WAIT_V(8); PG8_WAIT_L(0); PG8_BAR; PG8_MMA(0, 0, At, B0); PG8_MMA(0, 1, At, B1); PG8_BAR; PG8_SCHED;
            PG8_LDA(At, 1, 1); PG8_STAGE(PG8_SB(1, 0), b3, voffB); PG8_STAGE(PG8_SB(1, 1), b3 + hB, voffB); PG8_STAGE(PG8_SA(1, 0), a3, voffA);
            PG8_WAIT_V(8); PG8_WAIT_L(0); PG8_BAR; PG8_MMA(1, 0, At, B0); PG8_MMA(1, 1, At, B1); PG8_BAR; PG8_SCHED;
        }
        if (wr == 0) PG8_BAR;
        E(acc, cur, wr, wc, fr, fq);
        if (!has_next) break;
#pragma unroll
        for (int a = 0; a < 2; ++a)
#pragma unroll
            for (int b = 0; b < 2; ++b)
#pragma unroll
                for (int m = 0; m < 4; ++m)
#pragma unroll
                    for (int n = 0; n < 2; ++n) acc[a][b][m][n] = (f32x4){0.f, 0.f, 0.f, 0.f};
        cur = nxt; cA = nA; cB = nB; ++ui;
        if (wr == 1) PG8_BAR;
    }
    PG8_WAIT_V(0);
    PG8_BAR;
#undef PG8_SA
#undef PG8_SB
#undef PG8_STAGE
#undef PG8_LDA
#undef PG8_LDB
#undef PG8_MMA
#undef PG8_WAIT_V
#undef PG8_WAIT_L
#undef PG8_BAR
#undef PG8_SCHED
}
}

using pg8::bf16_t; using pg8::f32x4; using pg8::u32x4; using pg8::u32x2; using pg8::bf16x8; using pg8::Unit; using pg8::cvt_pk_bf16;
#define LAS __attribute__((address_space(3)))

constexpr int DM = 1024, BATCH = 8, SEQ = 4096, DEPTH = 4, MTOK = BATCH * SEQ;
constexpr int DSSM = 512, NG = 32, GH = 16, NP = 64, DSGU = 512, NHEAD = 8, SBLK = 128, DIN = 1536, DFF = 2816, PLE = 256;
constexpr int TC = 32;
constexpr int NROW = MTOK / TC;
constexpr int NCH = SEQ / TC;
constexpr int UAP = TC * GH + 2 * NP;
constexpr float ALPHA = 1.681792830507429f;
constexpr float LN_EPS = 1e-5f;
constexpr int NWAVES = 8, NTHR = 512;
constexpr int LDS_BYTES = 147456 + 64, LDS_MISC = 147456;

constexpr size_t MiB = 1u << 20;
constexpr size_t WS_WIN = 0, WS_WGLU = 12 * MiB, WS_WOUT = 14 * MiB, WS_WGU = 22 * MiB, WS_WD = 66 * MiB, WS_WPLE = 88 * MiB, WS_WPG = 90 * MiB, WS_WSGU = 98 * MiB;
constexpr size_t WS_E = 99 * MiB, WS_BBAR = 102 * MiB, WS_KS = 103 * MiB;
constexpr size_t WS_KM = 108 * MiB, WS_PT = 128 * MiB, WS_PBF = 136 * MiB, WS_H = 152 * MiB;
constexpr size_t WS_R = 216 * MiB;
constexpr int GPP = PLE + DFF;
constexpr size_t WS_G = WS_R, WS_GT = WS_R + 192 * MiB;
constexpr size_t WS_UA = WS_R, WS_US = WS_R + 40 * MiB, WS_VT = WS_R + 72 * MiB, WS_SLOC = WS_R + 104 * MiB, WS_YMIX = WS_R + 120 * MiB;
constexpr size_t WS_CTL = WS_R + 256 * MiB, CTL_BYTES = 6 * MiB;
constexpr size_t WS_CSI = WS_CTL + 65536;
constexpr size_t WS_ST = WS_CTL + MiB;
constexpr size_t WS_SSQ = WS_CTL + 5 * MiB + 512 * 1024;
constexpr size_t WS_CS = WS_CTL + 6 * MiB;
constexpr size_t WS_END = WS_CTL + 7 * MiB;
constexpr int CSO_IN = 0, BWO_IN = 1536, CSO_PG = 3072, BWO_PG = 4096, CSO_GU = 5120, BWO_GU = 10752, CS_L = 16384;

constexpr int N_PHASES_C = 2 + 8 * 4 + 1;
struct Args { const float* in[31]; float* out; unsigned char* ws; int lo, hi; };

__device__ __forceinline__ float bf_lo(unsigned w) { return __uint_as_float(w << 16); }
__device__ __forceinline__ float bf_hi(unsigned w) { return __uint_as_float(w & 0xffff0000u); }
__device__ __forceinline__ float sigm(float x) { return __builtin_amdgcn_rcpf(1.f + __builtin_amdgcn_exp2f(-1.4426950408889634f * x)); }
__device__ __forceinline__ float gelu_t(float x) { const float u = x * (1.f + 0.044715f * x * x); return x * __builtin_amdgcn_rcpf(1.f + __builtin_amdgcn_exp2f(-2.3022081985f * u)); }
__device__ __forceinline__ float wave_sum(float v) {
#pragma unroll
    for (int o = 1; o < 64; o <<= 1) v += __shfl_xor(v, o);
    return v;
}
__device__ __forceinline__ u32x4 pack8(const f32x4& a, const f32x4& b) { u32x4 w; w.x = cvt_pk_bf16(a[0], a[1]); w.y = cvt_pk_bf16(a[2], a[3]); w.z = cvt_pk_bf16(b[0], b[1]); w.w = cvt_pk_bf16(b[2], b[3]); return w; }

struct RowStat { float mu, rs; };
typedef long long i64;
__device__ __forceinline__ RowStat row_stat(const i64* ST, int r) { const i64 ta = ST[2 * r], tq = ST[2 * r + 1]; const float mu = (float)ta * (1.f / (1024.f * 16777216.f)); const float var = fmaxf((float)tq * (1.f / (1024.f * 16777216.f)) - mu * mu, 0.f); RowStat o; o.mu = mu; o.rs = 1.f / sqrtf(var + LN_EPS); return o; }
__device__ __forceinline__ void row_stats8(const i64* ST, int row0, RowStat (&rs)[8]) {
    i64 ta[8], tq[8];
#pragma unroll
    for (int i = 0; i < 8; ++i) { const int r = row0 + (i >> 2) * 128 + (i & 3) * 16; ta[i] = ST[2 * r]; tq[i] = ST[2 * r + 1]; }
#pragma unroll
    for (int i = 0; i < 8; ++i) { const float mu = (float)ta[i] * (1.f / (1024.f * 16777216.f)); const float var = fmaxf((float)tq[i] * (1.f / (1024.f * 16777216.f)) - mu * mu, 0.f); rs[i].mu = mu; rs[i].rs = 1.f / sqrtf(var + LN_EPS); }
}
__device__ __forceinline__ LAS float* red_ptr() { extern __shared__ __attribute__((aligned(16))) unsigned char lds_raw[]; return (LAS float*)((LAS unsigned char*)lds_raw + 131072); }
__device__ __forceinline__ void wg_reduce_rows(LAS float* RED, const float (&a)[8], const float (&q)[8], int wr, int wc, int fr, int fq, float& oa, float& oq) {
#pragma unroll
    for (int i = 0; i < 8; ++i) { float x = a[i], y = q[i]; x += __shfl_xor(x, 16); x += __shfl_xor(x, 32); y += __shfl_xor(y, 16); y += __shfl_xor(y, 32);
        if (fq == 0) { const int rl = (i >> 2) * 128 + wr * 64 + (i & 3) * 16 + fr; RED[(rl * 4 + wc) * 2] = x; RED[(rl * 4 + wc) * 2 + 1] = y; } }
    asm volatile("s_waitcnt lgkmcnt(0)" ::: "memory"); __builtin_amdgcn_s_barrier(); asm volatile("" ::: "memory");
    const int t = (wr * 4 + wc) * 64 + fq * 16 + fr; oa = 0.f; oq = 0.f;
    if (t < 256) { const f32x4 u = *(LAS f32x4*)(RED + t * 8), v = *(LAS f32x4*)(RED + t * 8 + 4); oa = (u[0] + u[2]) + (v[0] + v[2]); oq = (u[1] + u[3]) + (v[1] + v[3]); }
    asm volatile("s_waitcnt lgkmcnt(0)" ::: "memory"); __builtin_amdgcn_s_barrier(); asm volatile("" ::: "memory");
}
typedef const f32x4 (&AccRef)[2][2][4][2];
struct EpiWin { static constexpr bool PERM = true; static constexpr int MID_T = -1;
    bf16_t* UA; bf16_t* US; const i64* ST; const float* cs; const float* bw;
    __device__ __forceinline__ void operator()(AccRef acc, const Unit& u, int wr, int wc, int fr, int fq) const {
        const int row0 = u.pm * 256 + wr * 64 + fr, col0 = u.pn * 256 + wc * 32 + 8 * fq;
        RowStat rs8[8]; row_stats8(ST, row0, rs8);
#pragma unroll
        for (int bj = 0; bj < 2; ++bj) { const int c = col0 + bj * 128;
            const f32x4 c0 = *(const f32x4*)(cs + c), c1 = *(const f32x4*)(cs + c + 4), b0 = *(const f32x4*)(bw + c), b1 = *(const f32x4*)(bw + c + 4);
#pragma unroll
            for (int ai = 0; ai < 2; ++ai)
#pragma unroll
                for (int m = 0; m < 4; ++m) { const int r = row0 + ai * 128 + m * 16; const RowStat rs = rs8[ai * 4 + m];
                    f32x4 v0 = (acc[ai][bj][m][0] - c0 * rs.mu) * rs.rs + b0, v1 = (acc[ai][bj][m][1] - c1 * rs.mu) * rs.rs + b1;
                    if (u.pn < 2) { *(u32x4*)(UA + ((size_t)(c >> 4) * NROW + (r >> 5)) * UAP + (r & 31) * 16 + (c & 15)) = pack8(v0, v1); }
                    else {
#pragma unroll
                        for (int j = 0; j < 4; ++j) { v0[j] = gelu_t(v0[j]); v1[j] = gelu_t(v1[j]); }
                        *(u32x4*)(US + (size_t)r * DSGU + (c - 512)) = pack8(v0, v1); }
                    asm volatile("" ::: "memory"); } }
    }
};
struct EpiVT { static constexpr bool PERM = true; static constexpr int MID_T = -1;
    bf16_t* VT; const i64* ST; const float* cs; const float* bw;
    __device__ __forceinline__ void operator()(AccRef acc, const Unit& u, int wr, int wc, int fr, int fq) const {
        const int row0 = u.pm * 256 + wr * 64 + fr, col0 = u.pn * 256 + wc * 32 + 8 * fq;
#pragma unroll
        for (int bj = 0; bj < 2; ++bj) { const int c = col0 + bj * 128; float mu[8], rsd[8];
#pragma unroll
            for (int j = 0; j < 8; ++j) { const RowStat t = row_stat(ST, c + j); mu[j] = t.mu; rsd[j] = t.rs; }
#pragma unroll
            for (int ai = 0; ai < 2; ++ai)
#pragma unroll
                for (int m = 0; m < 4; ++m) { const int r = row0 + ai * 128 + m * 16; const float cc = cs[r], bb = bw[r]; f32x4 v0, v1;
#pragma unroll
                    for (int j = 0; j < 4; ++j) { v0[j] = gelu_t((acc[ai][bj][m][0][j] - cc * mu[j]) * rsd[j] + bb); v1[j] = gelu_t((acc[ai][bj][m][1][j] - cc * mu[4 + j]) * rsd[4 + j] + bb); }
                    *(u32x4*)(VT + ((size_t)(c >> 7) * 512 + r) * 128 + (c & 127)) = pack8(v0, v1);
                    asm volatile("" ::: "memory"); } }
    }
};
struct EpiGate { static constexpr bool PERM = true; static constexpr int MID_T = -1;
    bf16_t* GT; const float* bias; const i64* ST; const float* cs; const float* bw;
    __device__ __forceinline__ void operator()(AccRef acc, const Unit& u, int wr, int wc, int fr, int fq) const {
        const int row0 = u.pm * 256 + wr * 64 + fr, col0 = u.pn * 256 + wc * 32 + 8 * fq;
        RowStat rs8[8]; row_stats8(ST, row0, rs8);
#pragma unroll
        for (int bj = 0; bj < 2; ++bj) { const int c = col0 + bj * 128;
            const f32x4 c0 = *(const f32x4*)(cs + c), c1 = *(const f32x4*)(cs + c + 4);
            const f32x4 b0 = *(const f32x4*)(bw + c) + *(const f32x4*)(bias + c), b1 = *(const f32x4*)(bw + c + 4) + *(const f32x4*)(bias + c + 4);
#pragma unroll
            for (int ai = 0; ai < 2; ++ai)
#pragma unroll
                for (int m = 0; m < 4; ++m) { const int r = row0 + ai * 128 + m * 16; const RowStat rs = rs8[ai * 4 + m];
                    f32x4 v0 = (acc[ai][bj][m][0] - c0 * rs.mu) * rs.rs + b0, v1 = (acc[ai][bj][m][1] - c1 * rs.mu) * rs.rs + b1;
#pragma unroll
                    for (int j = 0; j < 4; ++j) { v0[j] = sigm(v0[j]); v1[j] = sigm(v1[j]); }
                    *(u32x4*)(GT + (size_t)r * DM + c) = pack8(v0, v1);
                    asm volatile("" ::: "memory"); } }
    }
};
template <int ACT> struct EpiBf { static constexpr bool PERM = true; static constexpr int MID_T = -1;
    bf16_t* O; int ldc; const float* bias;
    __device__ __forceinline__ void operator()(AccRef acc, const Unit& u, int wr, int wc, int fr, int fq) const {
        const int row0 = u.pm * 256 + wr * 64 + fr, col0 = u.pn * 256 + wc * 32 + 8 * fq;
        f32x4 bv[2][2];
#pragma unroll
        for (int bj = 0; bj < 2; ++bj)
#pragma unroll
            for (int n = 0; n < 2; ++n) bv[bj][n] = (ACT == 2) ? *(const f32x4*)(bias + col0 + bj * 128 + 4 * n) : (f32x4){0.f, 0.f, 0.f, 0.f};
#pragma unroll
        for (int ai = 0; ai < 2; ++ai)
#pragma unroll
            for (int m = 0; m < 4; ++m) { bf16_t* rowp = O + (size_t)(row0 + ai * 128 + m * 16) * ldc + col0;
#pragma unroll
                for (int bj = 0; bj < 2; ++bj) { f32x4 v0 = acc[ai][bj][m][0] + bv[bj][0], v1 = acc[ai][bj][m][1] + bv[bj][1];
#pragma unroll
                    for (int j = 0; j < 4; ++j) { if (ACT == 1) { v0[j] = gelu_t(v0[j]); v1[j] = gelu_t(v1[j]); } if (ACT == 2) { v0[j] = sigm(v0[j]); v1[j] = sigm(v1[j]); } }
                    *(u32x4*)(rowp + bj * 128) = pack8(v0, v1); }
                asm volatile("" ::: "memory"); }
    }
};
struct EpiSloc { static constexpr bool PERM = false; static constexpr int MID_T = -1;
    float* SL;
    __device__ __forceinline__ void operator()(AccRef acc, const Unit& u, int wr, int wc, int fr, int fq) const {
        const int row0 = u.pm * 256 + wr * 64 + fr, col0 = wc * 32 + 4 * fq;
#pragma unroll
        for (int ai = 0; ai < 2; ++ai)
#pragma unroll
            for (int m = 0; m < 4; ++m) { float* rowp = SL + (size_t)(row0 + ai * 128 + m * 16) * 128 + col0;
#pragma unroll
                for (int n = 0; n < 2; ++n) *(f32x4*)(rowp + n * 16) = acc[ai][0][m][n]; }
    }
};
struct EpiY { static constexpr bool PERM = true; static constexpr int MID_T = -1;
    bf16_t* YA; int g;
    __device__ __forceinline__ void operator()(AccRef acc, const Unit& u, int wr, int wc, int fr, int fq) const {
        const int row0 = u.pm * 256 + wr * 64 + fr, col0 = u.pn * 256 + wc * 32 + 8 * fq;
#pragma unroll
        for (int ai = 0; ai < 2; ++ai)
#pragma unroll
            for (int m = 0; m < 4; ++m) { const int R = row0 + ai * 128 + m * 16;
#pragma unroll
                for (int bj = 0; bj < 2; ++bj) { const int n = col0 + bj * 128; f32x4 v0 = acc[ai][bj][m][0], v1 = acc[ai][bj][m][1];
#pragma unroll
                    for (int j = 0; j < 4; ++j) { v0[j] = gelu_t(v0[j]); v1[j] = gelu_t(v1[j]); }
                    *(u32x4*)(YA + (size_t)(R * TC + (n >> 4)) * DSSM + g * 16 + (n & 15)) = pack8(v0, v1); }
                asm volatile("" ::: "memory"); }
    }
};
struct EpiGlu { static constexpr bool PERM = true; static constexpr int MID_T = -1;
    const bf16_t* YA; bf16_t* YM; i64* SSQ;
    __device__ __forceinline__ void operator()(AccRef acc, const Unit& u, int wr, int wc, int fr, int fq) const {
        const int row0 = u.pm * 256 + wr * 64 + fr, col0 = u.pn * 256 + wc * 32 + 8 * fq;
        float qq[8], zz[8];
#pragma unroll
        for (int i = 0; i < 8; ++i) { qq[i] = 0.f; zz[i] = 0.f; }
#pragma unroll
        for (int ai = 0; ai < 2; ++ai)
#pragma unroll
            for (int m = 0; m < 4; ++m) { const int r = row0 + ai * 128 + m * 16; const size_t off = (size_t)r * DSSM + col0; float q = 0.f;
#pragma unroll
                for (int bj = 0; bj < 2; ++bj) { const u32x4 y = *(const u32x4*)(YA + off + bj * 128); f32x4 v0 = acc[ai][bj][m][0], v1 = acc[ai][bj][m][1];
                    v0[0] = bf_lo(y.x) * sigm(v0[0]); v0[1] = bf_hi(y.x) * sigm(v0[1]); v0[2] = bf_lo(y.y) * sigm(v0[2]); v0[3] = bf_hi(y.y) * sigm(v0[3]);
                    v1[0] = bf_lo(y.z) * sigm(v1[0]); v1[1] = bf_hi(y.z) * sigm(v1[1]); v1[2] = bf_lo(y.w) * sigm(v1[2]); v1[3] = bf_hi(y.w) * sigm(v1[3]);
                    q += ((v0[0] * v0[0] + v0[1] * v0[1]) + (v0[2] * v0[2] + v0[3] * v0[3])) + ((v1[0] * v1[0] + v1[1] * v1[1]) + (v1[2] * v1[2] + v1[3] * v1[3]));
                    *(u32x4*)(YM + (size_t)r * DM + col0 + bj * 128) = pack8(v0, v1); }
                qq[ai * 4 + m] = q;
                if (m == 3) asm volatile("" ::: "memory"); }
        float oa, oq; wg_reduce_rows(red_ptr(), zz, qq, wr, wc, fr, fq, oa, oq);
        const int t = (wr * 4 + wc) * 64 + fq * 16 + fr; if (t < 256) (void)__hip_atomic_fetch_add(SSQ + u.pm * 256 + t, (i64)(oq * 16777216.f), __ATOMIC_RELAXED, __HIP_MEMORY_SCOPE_AGENT);
    }
};
template <bool HAS_PLE, bool OUT_F32> struct EpiRes { static constexpr bool PERM = true; static constexpr int MID_T = HAS_PLE ? 4 : 8;
    __device__ __forceinline__ void mid(f32x4 (&acc)[2][2][4][2], const Unit& u, int wr, int wc, int fr, int fq) const {
        asm volatile("" : "+v"(fr), "+v"(fq));
        const int row0 = u.pm * 256 + wr * 64 + fr, col0 = u.pn * 256 + wc * 32 + 8 * fq;
        if constexpr (!HAS_PLE) {
#pragma unroll
            for (int ai = 0; ai < 2; ++ai)
#pragma unroll
                for (int m = 0; m < 4; ++m) { const float sc = 1.f / sqrtf((float)SSQ[row0 + ai * 128 + m * 16] * (1.f / (512.f * 16777216.f)) + LN_EPS);
#pragma unroll
                    for (int bj = 0; bj < 2; ++bj) { acc[ai][bj][m][0] = acc[ai][bj][m][0] * sc; acc[ai][bj][m][1] = acc[ai][bj][m][1] * sc; } }
            return; }
#pragma unroll
        for (int ai = 0; ai < 2; ++ai)
#pragma unroll
            for (int m = 0; m < 4; ++m)
#pragma unroll
                for (int bj = 0; bj < 2; ++bj) { const u32x4 y = *(const u32x4*)(PL + (size_t)(row0 + ai * 128 + m * 16) * DM + col0 + bj * 128);
                    acc[ai][bj][m][0][0] *= bf_lo(y.x); acc[ai][bj][m][0][1] *= bf_hi(y.x); acc[ai][bj][m][0][2] *= bf_lo(y.y); acc[ai][bj][m][0][3] *= bf_hi(y.y);
                    acc[ai][bj][m][1][0] *= bf_lo(y.z); acc[ai][bj][m][1][1] *= bf_hi(y.z); acc[ai][bj][m][1][2] *= bf_lo(y.w); acc[ai][bj][m][1][3] *= bf_hi(y.w);
                    if (bj == 1 && (m & 1)) asm volatile("" ::: "memory"); }
    }
    bf16_t* Hh; const bf16_t* PL; float* Xf; const i64* STin; const float* gin; const float* bin; i64* STout; const i64* SSQ;
    __device__ __forceinline__ void operator()(AccRef acc, const Unit& u, int wr, int wc, int fr, int fq) const {
        const int row0 = u.pm * 256 + wr * 64 + fr, col0 = u.pn * 256 + wc * 32 + 8 * fq;
        float ssum[8], ssq[8];
#pragma unroll
        for (int i = 0; i < 8; ++i) { ssum[i] = 0.f; ssq[i] = 0.f; }
        RowStat rs8[8]; row_stats8(STin, row0, rs8);
#pragma unroll
        for (int bj = 0; bj < 2; ++bj) { const int c = col0 + bj * 128;
            const f32x4 g0 = *(const f32x4*)(gin + c), g1 = *(const f32x4*)(gin + c + 4), b0 = *(const f32x4*)(bin + c), b1 = *(const f32x4*)(bin + c + 4);
#pragma unroll
            for (int ai = 0; ai < 2; ++ai)
#pragma unroll
                for (int m = 0; m < 4; ++m) { const int r = row0 + ai * 128 + m * 16; const size_t o = (size_t)r * DM + c; const RowStat rs = rs8[ai * 4 + m];
                    const u32x4 hh = *(const u32x4*)(Hh + o);
                    f32x4 h0 = {bf_lo(hh.x), bf_hi(hh.x), bf_lo(hh.y), bf_hi(hh.y)}, h1 = {bf_lo(hh.z), bf_hi(hh.z), bf_lo(hh.w), bf_hi(hh.w)};
                    h0 = (h0 - rs.mu) * rs.rs * g0 + b0; h1 = (h1 - rs.mu) * rs.rs * g1 + b1;
                    f32x4 v0 = h0 * ALPHA + acc[ai][bj][m][0], v1 = h1 * ALPHA + acc[ai][bj][m][1];
                    if (OUT_F32) { *(f32x4*)(Xf + o) = v0; *(f32x4*)(Xf + o + 4) = v1; }
                    else { *(u32x4*)(Hh + o) = pack8(v0, v1);
                        ssum[ai * 4 + m] += ((v0[0] + v0[1]) + (v0[2] + v0[3])) + ((v1[0] + v1[1]) + (v1[2] + v1[3]));
                        ssq[ai * 4 + m] += ((v0[0] * v0[0] + v0[1] * v0[1]) + (v0[2] * v0[2] + v0[3] * v0[3])) + ((v1[0] * v1[0] + v1[1] * v1[1]) + (v1[2] * v1[2] + v1[3] * v1[3])); }
                    if (m == 3 && ai == 1) asm volatile("" ::: "memory"); } }
        if (!OUT_F32) { float oa, oq; wg_reduce_rows(red_ptr(), ssum, ssq, wr, wc, fr, fq, oa, oq);
            const int t = (wr * 4 + wc) * 64 + fq * 16 + fr;
            if (t < 256) { const int r = u.pm * 256 + t; (void)__hip_atomic_fetch_add(STout + 2 * r, (i64)(oa * 16777216.f), __ATOMIC_RELAXED, __HIP_MEMORY_SCOPE_AGENT); (void)__hip_atomic_fetch_add(STout + 2 * r + 1, (i64)(oq * 16777216.f), __ATOMIC_RELAXED, __HIP_MEMORY_SCOPE_AGENT); } }
    }
};
struct EpiPle { static constexpr bool PERM = true; static constexpr int MID_T = -1;
    bf16_t* GT;
    __device__ __forceinline__ void operator()(AccRef acc, const Unit& u, int wr, int wc, int fr, int fq) const {
        const int row0 = u.pm * 256 + wr * 64 + fr, col0 = u.pn * 256 + wc * 32 + 8 * fq;
#pragma unroll
        for (int ai = 0; ai < 2; ++ai)
#pragma unroll
            for (int m = 0; m < 4; ++m) { const size_t off = (size_t)(row0 + ai * 128 + m * 16) * DM + col0;
#pragma unroll
                for (int bj = 0; bj < 2; ++bj) { const u32x4 y = *(const u32x4*)(GT + off + bj * 128); f32x4 v0 = acc[ai][bj][m][0], v1 = acc[ai][bj][m][1];
                    v0[0] *= bf_lo(y.x); v0[1] *= bf_hi(y.x); v0[2] *= bf_lo(y.y); v0[3] *= bf_hi(y.y);
                    v1[0] *= bf_lo(y.z); v1[1] *= bf_hi(y.z); v1[2] *= bf_lo(y.w); v1[3] *= bf_hi(y.w);
                    *(u32x4*)(GT + off + bj * 128) = pack8(v0, v1); }
                asm volatile("" ::: "memory"); }
    }
};
struct EpiGU { static constexpr bool PERM = true; static constexpr int MID_T = -1;
    bf16_t* G; const i64* ST; const float* cs; const float* bw;
    __device__ __forceinline__ void operator()(AccRef acc, const Unit& u, int wr, int wc, int fr, int fq) const {
        const int row0 = u.pm * 256 + wr * 64 + fr, col0 = u.pn * 128 + wc * 32 + 8 * fq, cg = u.pn * 256 + wc * 32 + 8 * fq;
        const f32x4 cg0 = *(const f32x4*)(cs + cg), cg1 = *(const f32x4*)(cs + cg + 4), bg0 = *(const f32x4*)(bw + cg), bg1 = *(const f32x4*)(bw + cg + 4);
        const f32x4 cu0 = *(const f32x4*)(cs + cg + 128), cu1 = *(const f32x4*)(cs + cg + 132), bu0 = *(const f32x4*)(bw + cg + 128), bu1 = *(const f32x4*)(bw + cg + 132);
        RowStat rs8[8]; row_stats8(ST, row0, rs8);
#pragma unroll
        for (int ai = 0; ai < 2; ++ai)
#pragma unroll
            for (int m = 0; m < 4; ++m) { const int r = row0 + ai * 128 + m * 16; const RowStat rs = rs8[ai * 4 + m];
                const f32x4 ga = (acc[ai][0][m][0] - cg0 * rs.mu) * rs.rs + bg0, gb = (acc[ai][0][m][1] - cg1 * rs.mu) * rs.rs + bg1;
                const f32x4 ua = (acc[ai][1][m][0] - cu0 * rs.mu) * rs.rs + bu0, ub = (acc[ai][1][m][1] - cu1 * rs.mu) * rs.rs + bu1;
                f32x4 v0, v1;
#pragma unroll
                for (int j = 0; j < 4; ++j) { v0[j] = ga[j] * sigm(ga[j]) * ua[j]; v1[j] = gb[j] * sigm(gb[j]) * ub[j]; }
                __builtin_nontemporal_store(pack8(v0, v1), (u32x4*)(G + (size_t)r * GPP + PLE + col0));
                asm volatile("" ::: "memory"); }
    }
};

__device__ __forceinline__ unsigned f2bf(float f) { unsigned u = __builtin_bit_cast(unsigned, f); return (u + 0x7fffu + ((u >> 16) & 1u)) >> 16; }
__device__ __forceinline__ unsigned pk2(float lo, float hi) { return f2bf(lo) | (f2bf(hi) << 16); }
__device__ __forceinline__ void transpose_item(const float* W, int K, int N, bf16_t* WT, int k0, int n0, int dst_row0, LAS float* scr, int lane, const float* gk = nullptr, const float* bk = nullptr, i64* cs = nullptr, i64* bw = nullptr, int ldw = 0, int koff = 0) {
    if (ldw == 0) ldw = K;
#pragma unroll 8
    for (int i = 0; i < 32; ++i) { const int kk = 2 * i + (lane >> 5); scr[kk * 33 + (lane & 31)] = __builtin_nontemporal_load(W + (size_t)(k0 + kk) * N + n0 + (lane & 31)); }
    asm volatile("s_waitcnt lgkmcnt(0)" ::: "memory");
    const int c = lane & 7;
    float gs[8];
#pragma unroll
    for (int i = 0; i < 8; ++i) gs[i] = gk ? gk[k0 + 8 * c + i] : 1.f;
    if (gk && cs) { const int n = lane & 31; const float* vv = (lane < 32) ? gk : bk; float a = 0.f;
#pragma unroll 8
        for (int kk = 0; kk < 64; ++kk) a += scr[kk * 33 + n] * vv[k0 + kk];
        (void)__hip_atomic_fetch_add(((lane < 32) ? cs : bw) + dst_row0 + n, (i64)(a * 4294967296.f), __ATOMIC_RELAXED, __HIP_MEMORY_SCOPE_AGENT); }
#pragma unroll
    for (int j = 0; j < 4; ++j) { const int n = (lane >> 3) + 8 * j; const LAS float* sp = scr + (8 * c) * 33 + n;
        u32x4 o; o.x = pk2(sp[0 * 33] * gs[0], sp[1 * 33] * gs[1]); o.y = pk2(sp[2 * 33] * gs[2], sp[3 * 33] * gs[3]); o.z = pk2(sp[4 * 33] * gs[4], sp[5 * 33] * gs[5]); o.w = pk2(sp[6 * 33] * gs[6], sp[7 * 33] * gs[7]);
        __builtin_nontemporal_store(o, (u32x4*)(WT + (size_t)(dst_row0 + n) * ldw + koff + k0 + 8 * c)); }
    asm volatile("s_waitcnt lgkmcnt(0)" ::: "memory");
}
__device__ __forceinline__ void raw_row(const float* xrow, bf16_t* brow, i64* st, int lane) {
    const f32x4* xr = (const f32x4*)xrow + lane; float a = 0.f, q = 0.f;
#pragma unroll
    for (int j = 0; j < 4; ++j) { const f32x4 v = __builtin_nontemporal_load(xr + 64 * j); a += (v[0] + v[1]) + (v[2] + v[3]); q += (v[0] * v[0] + v[1] * v[1]) + (v[2] * v[2] + v[3] * v[3]);
        u32x2 w; w.x = cvt_pk_bf16(v[0], v[1]); w.y = cvt_pk_bf16(v[2], v[3]); ((u32x2*)brow)[lane + 64 * j] = w; }
    a = wave_sum(a); q = wave_sum(q);
    if (lane == 0) { st[0] = (i64)(a * 16777216.f); st[1] = (i64)(q * 16777216.f); }
}
template <bool WF32, bool WBF>
__device__ __forceinline__ void ln_row(const float* xrow, const float* g, const float* b, float* frow, bf16_t* brow, int lane) {
    const f32x4* xr = (const f32x4*)xrow + lane;
    f32x4 v[4]; float s = 0.f;
#pragma unroll
    for (int j = 0; j < 4; ++j) { v[j] = xr[64 * j]; s += (v[j][0] + v[j][1]) + (v[j][2] + v[j][3]); }
    const float mean = wave_sum(s) * (1.f / DM); float s2 = 0.f;
#pragma unroll
    for (int j = 0; j < 4; ++j) { v[j] = v[j] - mean; s2 += (v[j][0] * v[j][0] + v[j][1] * v[j][1]) + (v[j][2] * v[j][2] + v[j][3] * v[j][3]); }
    const float rstd = 1.f / sqrtf(wave_sum(s2) * (1.f / DM) + LN_EPS);
#pragma unroll
    for (int j = 0; j < 4; ++j) { const f32x4 gg = ((const f32x4*)g)[lane + 64 * j], bb = ((const f32x4*)b)[lane + 64 * j]; const f32x4 o = v[j] * rstd * gg + bb;
        if (WF32) ((f32x4*)frow)[lane + 64 * j] = o; if (WBF) { u32x2 w; w.x = cvt_pk_bf16(o[0], o[1]); w.y = cvt_pk_bf16(o[2], o[3]); ((u32x2*)brow)[lane + 64 * j] = w; } }
}


#define XB_TMO      128
#define XB_XCNT(j)  (256  + 64 * (j))
#define XB_XSUB(j)  (1280 + 64 * (j))
#define XB_XGEN(j)  (2304 + 64 * (j))
#define XB_TOP      3328
#define XB_TOPGEN   3392
#define XCD_BAR_WORDS 3456
#define XB_SPIN_CAP (1u << 20)
__device__ __forceinline__ unsigned xb_ld(unsigned* p)              { return __hip_atomic_load(p, __ATOMIC_RELAXED, __HIP_MEMORY_SCOPE_AGENT); }
__device__ __forceinline__ unsigned xb_add(unsigned* p, unsigned v) { return __hip_atomic_fetch_add(p, v, __ATOMIC_RELAXED, __HIP_MEMORY_SCOPE_AGENT); }
__device__ __forceinline__ unsigned xb_xcc_id() { return (unsigned)__builtin_amdgcn_s_getreg((3 << 11) | 20) & 0xFu; }
#define XB_SPIN(cond, bar) do { unsigned _sp = 0; while (cond) { __builtin_amdgcn_s_sleep(1); \
    if ((++_sp & 255u) == 0u) { if (xb_ld(&(bar)[XB_TMO])) break; if (_sp > XB_SPIN_CAP) { atomicAdd(&(bar)[XB_TMO], 1u); break; } } } } while (0)
struct XcdBarrier { unsigned* bar; unsigned x; volatile LAS unsigned* st; };
__device__ __forceinline__ XcdBarrier xcd_barrier_post(unsigned* bar, volatile LAS unsigned* st) {
    XcdBarrier b; b.bar = bar; b.x = xb_xcc_id(); b.st = st;
    if (threadIdx.x == 0) (void)xb_add(&bar[XB_XCNT(b.x)], 1u);
    return b;
}
__device__ __forceinline__ void xcd_barrier_complete(unsigned* bar, unsigned x, unsigned& nloc, unsigned& nx) {
    const unsigned G = gridDim.x * gridDim.y * gridDim.z;
    unsigned sum, cnt, mine, sp = 0u;
    for (;;) {
        sum = 0u; cnt = 0u; mine = 0u;
#pragma unroll
        for (unsigned j = 0; j < 16; ++j) { const unsigned c = xb_ld(&bar[XB_XCNT(j)]); sum += c; cnt += (c > 0u) ? 1u : 0u; mine = (j == x) ? c : mine; }
        if (sum == G) break;
        __builtin_amdgcn_s_sleep(1);
        if ((++sp & 255u) == 0u) { if (xb_ld(&bar[XB_TMO])) break; if (sp > XB_SPIN_CAP) { atomicAdd(&bar[XB_TMO], 1u); break; } }
    }
    nloc = mine > 0u ? mine : 1u; nx = cnt > 0u ? cnt : 1u;
}
__device__ __forceinline__ void xcd_barrier(const XcdBarrier& b) {
    asm volatile("s_waitcnt vmcnt(0)" ::: "memory");
    __syncthreads();
    if (threadIdx.x == 0) {
        unsigned* bar = b.bar;
        __builtin_amdgcn_s_waitcnt(0);
        unsigned nloc = b.st[0], nx = b.st[1];
        if (nloc == 0u) { xcd_barrier_complete(bar, b.x, nloc, nx); b.st[0] = nloc; b.st[1] = nx; }
        const unsigned old = xb_add(&bar[XB_XSUB(b.x)], 1u);
        const unsigned gen = old / nloc;
        if (old + 1u == (gen + 1u) * nloc) {
            __builtin_amdgcn_fence(__ATOMIC_RELEASE, "agent");
            asm volatile("s_waitcnt vmcnt(0)" ::: "memory");
            const unsigned og = xb_add(&bar[XB_TOP], 1u);
            const unsigned tg = og / nx;
            if (og + 1u == (tg + 1u) * nx) xb_add(&bar[XB_TOPGEN], 1u);
            else XB_SPIN(xb_ld(&bar[XB_TOPGEN]) == tg, bar);
            __builtin_amdgcn_fence(__ATOMIC_ACQUIRE, "agent");
            xb_add(&bar[XB_XGEN(b.x)], 1u);
            asm volatile("s_waitcnt vmcnt(0)" ::: "memory");
        } else {
            XB_SPIN(xb_ld(&bar[XB_XGEN(b.x)]) == gen, bar);
            __builtin_amdgcn_fence(__ATOMIC_ACQUIRE, "agent");
            asm volatile("s_waitcnt vmcnt(0)" ::: "memory");
        }
    }
    __syncthreads();
}

__global__ void __launch_bounds__(NTHR, 2) mega_fwd(Args args) {
    extern __shared__ __attribute__((aligned(16))) unsigned char lds_raw[];
    LAS unsigned char* lds = (LAS unsigned char*)lds_raw;
    cg::grid_group grid = cg::this_grid();
    const int tid0 = threadIdx.x, wave = __builtin_amdgcn_readfirstlane(tid0 >> 6);
    const int G = gridDim.x, bx = blockIdx.x;
    const int gw = bx * NWAVES + wave, NGW = G * NWAVES;
    const size_t NGT = (size_t)G * NTHR;
    unsigned char* ws = args.ws;
    const float* const* in = args.in;
    float* X = args.out;
    bf16_t* H = (bf16_t*)(ws + WS_H);
    bf16_t* WIN = (bf16_t*)(ws + WS_WIN); bf16_t* WGLU = (bf16_t*)(ws + WS_WGLU); bf16_t* WOUT = (bf16_t*)(ws + WS_WOUT); bf16_t* WGU = (bf16_t*)(ws + WS_WGU);
    bf16_t* WD = (bf16_t*)(ws + WS_WD); bf16_t* WPG = (bf16_t*)(ws + WS_WPG); bf16_t* WSGU = (bf16_t*)(ws + WS_WSGU);
    float2* ET = (float2*)(ws + WS_E); float2* BBAR = (float2*)(ws + WS_BBAR); float* KS = (float*)(ws + WS_KS);
    bf16_t* KM = (bf16_t*)(ws + WS_KM); bf16_t* PT = (bf16_t*)(ws + WS_PT);
    bf16_t* GB = (bf16_t*)(ws + WS_G); bf16_t* GT = (bf16_t*)(ws + WS_GT);
    bf16_t* UA = (bf16_t*)(ws + WS_UA); bf16_t* US = (bf16_t*)(ws + WS_US); bf16_t* VT = (bf16_t*)(ws + WS_VT); float* SLOC = (float*)(ws + WS_SLOC); bf16_t* YMIX = (bf16_t*)(ws + WS_YMIX);
    bf16_t* YGLU = US; bf16_t* YACT = VT;
    float* CSV = (float*)(ws + WS_CS); i64* CSI = (i64*)(ws + WS_CSI); i64* STB = (i64*)(ws + WS_ST); i64* SSQB = (i64*)(ws + WS_SSQ);
    const int lo = args.lo, hi = args.hi;
    int ph = 0;
    volatile LAS unsigned* MISC = (volatile LAS unsigned*)(lds + LDS_MISC);
    if (tid0 < 16) MISC[tid0] = 0u;
    __syncthreads();
    XcdBarrier xbar; xbar.bar = (unsigned*)(ws + WS_CTL); xbar.x = 0; xbar.st = MISC;
    if (hi - lo > 1) xbar = xcd_barrier_post((unsigned*)(ws + WS_CTL), MISC);
#define PHASE_BEGIN if (lo <= ph && ph < hi) { const int kind_ = ph < 2 ? ph : (ph == N_PHASES_C - 1 ? 11 : 2 + (ph - 2) % 8); const int nrep_ = ((DOUBLE_MASK >> kind_) & 1) ? 2 : 1; for (int rep_ = 0; rep_ < nrep_; ++rep_) { int tid = tid0; asm volatile("" : "+v"(tid)); const int lane = tid & 63; const size_t gt = (size_t)bx * NTHR + tid; (void)lane; (void)gt;
#define PHASE_END   } if (ph + 1 < hi) { if (ph == 0) grid.sync(); else xcd_barrier(xbar); } } ++ph;

    PHASE_BEGIN
#if !defined(ONLY) || ONLY == 0
    {
        LAS float* scr = (LAS float*)(lds + wave * 16384);
        constexpr int I_IN = 16 * 48, I_GLU = 8 * 16, I_OUT = 16 * 32, I_GA = 16 * 88, I_DN = 44 * 32, I_PLE = 4 * 32, I_PG = 16 * 32;
        constexpr int I_L = I_IN + I_GLU + I_OUT + 2 * I_GA + I_DN + I_PLE + I_PG;
        for (int it = gw; it < DEPTH * I_L; it += NGW) {
            const int l = it / I_L; int r = it % I_L;
            if (r < I_IN) { const int nb = r % 48, kb = r / 48; transpose_item(in[4] + (size_t)l * DM * DIN, DM, DIN, WIN + (size_t)l * DIN * DM, 64 * kb, 32 * nb, 32 * nb, scr, lane, l ? in[29] + (l - 1) * DM : in[2], l ? in[30] + (l - 1) * DM : in[3], CSI + l * CS_L + CSO_IN, CSI + l * CS_L + BWO_IN); continue; } r -= I_IN;
            if (r < I_GLU) { const int nb = r % 16, kb = r / 16; transpose_item(in[13] + (size_t)l * DSSM * DSSM, DSSM, DSSM, WGLU + (size_t)l * DSSM * DSSM, 64 * kb, 32 * nb, 32 * nb, scr, lane); continue; } r -= I_GLU;
            if (r < I_OUT) { const int nb = r % 32, kb = r / 32; transpose_item(in[20] + (size_t)l * DM * DM, DM, DM, WOUT + (size_t)l * DM * DM, 64 * kb, 32 * nb, 32 * nb, scr, lane, kb < 8 ? in[18] + l * DSSM : nullptr); continue; } r -= I_OUT;
            if (r < I_GA) { const int nb = r % 88, kb = r / 88, n0 = 32 * nb; transpose_item(in[23] + (size_t)l * DM * DFF, DM, DFF, WGU + (size_t)l * 2 * DFF * DM, 64 * kb, n0, 256 * (n0 / 128) + (n0 % 128), scr, lane, in[21] + l * DM, in[22] + l * DM, CSI + l * CS_L + CSO_GU, CSI + l * CS_L + BWO_GU); continue; } r -= I_GA;
            if (r < I_GA) { const int nb = r % 88, kb = r / 88, n0 = 32 * nb; transpose_item(in[24] + (size_t)l * DM * DFF, DM, DFF, WGU + (size_t)l * 2 * DFF * DM, 64 * kb, n0, 256 * (n0 / 128) + 128 + (n0 % 128), scr, lane, in[21] + l * DM, in[22] + l * DM, CSI + l * CS_L + CSO_GU, CSI + l * CS_L + BWO_GU); continue; } r -= I_GA;
            if (r < I_DN) { const int nb = r % 32, kb = r / 32; transpose_item(in[25] + (size_t)l * DFF * DM, DFF, DM, WD + (size_t)l * DM * GPP, 64 * kb, 32 * nb, 32 * nb, scr, lane, nullptr, nullptr, nullptr, nullptr, GPP, PLE); continue; } r -= I_DN;
            if (r < I_PLE) { const int nb = r % 32, kb = r / 32; transpose_item(in[26] + (size_t)l * PLE * DM, PLE, DM, WD + (size_t)l * DM * GPP, 64 * kb, 32 * nb, 32 * nb, scr, lane, nullptr, nullptr, nullptr, nullptr, GPP, 0); continue; } r -= I_PLE;
            { const int nb = r % 32, kb = r / 32; transpose_item(in[27] + (size_t)l * DM * DM, DM, DM, WPG + (size_t)l * DM * DM, 64 * kb, 32 * nb, 32 * nb, scr, lane, in[21] + l * DM, in[22] + l * DM, CSI + l * CS_L + CSO_PG, CSI + l * CS_L + BWO_PG); }
        }
        for (int m = gw; m < MTOK; m += NGW) raw_row(in[0] + (size_t)m * DM, H + (size_t)m * DM, STB + 2 * (size_t)m, lane);
        for (size_t i = gt; i < (size_t)DEPTH * NG * NP; i += NGT) {
            const int lg = (int)(i / NP);
            const double dt = exp((double)in[7][lg]);
            const double are = in[5][i], aim = in[6][i];
            const double mag = exp(are * dt), abr = mag * cos(aim * dt), abi = mag * sin(aim * dt);
            const double nr = abr - 1.0, ni = abi, den = are * are + aim * aim;
            const double cr = (nr * are + ni * aim) / den, ci = (ni * are - nr * aim) / den;
            double er = 1.0, ei = 0.0;
            for (int k = 0; k <= TC; ++k) { ET[i * (TC + 1) + k] = make_float2((float)er, (float)ei); const double t = er * abr - ei * abi; ei = er * abi + ei * abr; er = t; }
            for (int h = 0; h < GH; ++h) { const double br = in[8][i * GH + h], bi = in[9][i * GH + h]; BBAR[i * GH + h] = make_float2((float)(cr * br - ci * bi), (float)(cr * bi + ci * br)); }
        }
        for (size_t i = gt; i < (size_t)DEPTH * NHEAD * SBLK * SBLK; i += NGT) { const int jj = (int)(i & 127), ii = (int)((i >> 7) & 127); WSGU[i] = (bf16_t)(((ii >> 6) >= (jj >> 6)) ? f2bf(in[16][i]) : 0u); }
    }
#endif
    PHASE_END
    PHASE_BEGIN
#if !defined(ONLY) || ONLY == 1
    for (size_t i = gt; i < (size_t)DEPTH * CS_L; i += NGT) CSV[i] = (float)((double)CSI[i] * (1.0 / 4294967296.0));
    for (size_t i4 = gt; i4 < (size_t)DEPTH * NG * TC * GH * GH / 4; i4 += NGT) {
        const size_t i = i4 * 4; const int hi0 = (int)(i & 15), ho = (int)((i >> 4) & 15), k = (int)((i >> 8) & 31), lg = (int)(i >> 13);
        const float* cre = in[10] + ((size_t)lg * GH + ho) * NP; const float* cim = in[11] + ((size_t)lg * GH + ho) * NP;
        f32x4 s = {0.f, 0.f, 0.f, 0.f};
#pragma unroll 8
        for (int p = 0; p < NP; ++p) { const float2 e = ET[((size_t)lg * NP + p) * (TC + 1) + k]; const float cr = cre[p], ci = cim[p];
            const float wr_ = cr * e.x - ci * e.y, wi_ = cr * e.y + ci * e.x;
            const f32x4 b01 = *(const f32x4*)(BBAR + ((size_t)lg * NP + p) * GH + hi0), b23 = *(const f32x4*)(BBAR + ((size_t)lg * NP + p) * GH + hi0 + 2);
            s[0] += wr_ * b01[0] - wi_ * b01[1]; s[1] += wr_ * b01[2] - wi_ * b01[3]; s[2] += wr_ * b23[0] - wi_ * b23[1]; s[3] += wr_ * b23[2] - wi_ * b23[3]; }
        if (k == 0 && ho >= hi0 && ho < hi0 + 4) s[ho - hi0] += in[12][lg * GH + ho];
        *(f32x4*)(KS + i) = s;
    }
#endif
    PHASE_END

    for (int l = 0; l < DEPTH; ++l) {
        PHASE_BEGIN
#if !defined(ONLY) || ONLY == 2
        {
            for (size_t e = gt; e < (size_t)NG * 512 * (UAP / 8); e += NGT) {
                const int k8 = (int)(e % (UAP / 8)), n = (int)((e / (UAP / 8)) % 512), g = (int)(e / ((UAP / 8) * 512));
                const int i = n >> 4, ho = n & 15, lg = l * NG + g; float v[8];
                if (k8 < 64) { const int j = k8 >> 1, h0 = (k8 & 1) * 8;
                    if (i >= j) { const float* src = KS + ((((size_t)lg * TC + (i - j)) * GH + ho) * GH + h0);
                        const f32x4 s0 = *(const f32x4*)src, s1 = *(const f32x4*)(src + 4);
#pragma unroll
                        for (int q = 0; q < 4; ++q) { v[q] = s0[q]; v[4 + q] = s1[q]; } }
                    else {
#pragma unroll
                        for (int q = 0; q < 8; ++q) v[q] = 0.f; } }
                else { const int q0 = (k8 - 64) * 8, part = q0 >> 6, p0 = q0 & 63;
                    const float* crp = in[10] + ((size_t)lg * GH + ho) * NP + p0; const float* cip = in[11] + ((size_t)lg * GH + ho) * NP + p0;
                    const f32x4 cr0 = *(const f32x4*)crp, cr1 = *(const f32x4*)(crp + 4), ci0 = *(const f32x4*)cip, ci1 = *(const f32x4*)(cip + 4);
#pragma unroll
                    for (int q = 0; q < 8; ++q) { const int p = p0 + q; const float2 a = ET[((size_t)lg * NP + p) * (TC + 1) + (i + 1)];
                        const float cr = q < 4 ? cr0[q & 3] : cr1[q & 3], ci = q < 4 ? ci0[q & 3] : ci1[q & 3];
                        v[q] = part ? -(cr * a.y + ci * a.x) : (cr * a.x - ci * a.y); } }
                u32x4 w; w.x = pk2(v[0], v[1]); w.y = pk2(v[2], v[3]); w.z = pk2(v[4], v[5]); w.w = pk2(v[6], v[7]);
                __builtin_nontemporal_store(w, (u32x4*)(KM + ((size_t)g * 512 + n) * UAP + k8 * 8));
            }
            for (size_t e = gt; e < (size_t)NG * 256 * 64; e += NGT) {
                const int k8 = (int)(e & 63), n = (int)((e >> 6) & 255), g = (int)(e >> 14), lg = l * NG + g; float v[8];
                if (n < 128) { const int part = n >> 6, p = n & 63, j = k8 >> 1, h0 = (k8 & 1) * 8; const float2 a = ET[((size_t)lg * NP + p) * (TC + 1) + (TC - 1 - j)];
                    const f32x4* bp = (const f32x4*)(BBAR + ((size_t)lg * NP + p) * GH + h0);
#pragma unroll
                    for (int q2 = 0; q2 < 4; ++q2) { const f32x4 b = bp[q2];
                        v[2 * q2] = part ? (a.x * b[1] + a.y * b[0]) : (a.x * b[0] - a.y * b[1]); v[2 * q2 + 1] = part ? (a.x * b[3] + a.y * b[2]) : (a.x * b[2] - a.y * b[3]); } }
                else {
#pragma unroll
                    for (int q = 0; q < 8; ++q) v[q] = 0.f; }
                u32x4 w; w.x = pk2(v[0], v[1]); w.y = pk2(v[2], v[3]); w.z = pk2(v[4], v[5]); w.w = pk2(v[6], v[7]);
                *(u32x4*)(PT + ((size_t)g * 256 + n) * 512 + k8 * 8) = w;
            }
            { pg8::Gemm g{H, WIN + (size_t)l * DIN * DM, MTOK, 1024, DM, DM, DM}; pg8::StaticOrder S; S.init(MTOK, 1024, G, bx); EpiWin E{UA, US, STB + (size_t)(2 * l) * MTOK * 2, CSV + l * CS_L + CSO_IN, CSV + l * CS_L + BWO_IN}; pg8::gemm_phase(lds, g, S, E); }
            { pg8::Gemm g{WIN + (size_t)l * DIN * DM + (size_t)1024 * DM, H, 512, MTOK, DM, DM, DM}; pg8::StaticOrder S; S.init(512, MTOK, G, bx); EpiVT E{VT, STB + (size_t)(2 * l) * MTOK * 2, CSV + l * CS_L + CSO_IN + 1024, CSV + l * CS_L + BWO_IN + 1024}; pg8::gemm_phase(lds, g, S, E); }
        }
#endif
        PHASE_END
        PHASE_BEGIN
#if !defined(ONLY) || ONLY == 3
        {
            const bf16_t* Wl = WSGU + (size_t)l * NHEAD * SBLK * SBLK;
            const float* lng = in[14] + l * DSGU; const float* lnb = in[15] + l * DSGU; const float* bs = in[17] + l * NHEAD * SBLK; const float* gsg = in[19] + l * DSGU;
            LAS float* ST = (LAS float*)(lds + 139264);
            for (int blk = bx; blk < MTOK / SBLK; blk += G) {
                const int tok0 = blk * SBLK;
                int tst_ = tid; asm volatile("" : "+v"(tst_));
#pragma unroll
                for (int hb = 0; hb < 2; ++hb) { u32x4 stg[8];
#pragma unroll
                    for (int j = 0; j < 8; ++j) { const int idx = tst_ + (hb * 8 + j) * NTHR, ch = idx >> 4, seg = idx & 15; stg[j] = *(const u32x4*)(VT + ((size_t)blk * 512 + ch) * 128 + seg * 8); }
#pragma unroll
                    for (int j = 0; j < 8; ++j) { const int idx = tst_ + (hb * 8 + j) * NTHR, ch = idx >> 4, seg = idx & 15; *(LAS u32x4*)(lds + ch * 272 + seg * 16) = stg[j]; } }
                __syncthreads();
                {
                    float s0 = 0.f, s1 = 0.f, q0 = 0.f, q1 = 0.f;
#pragma unroll 16
                    for (int cc = 0; cc < 64; ++cc) { const unsigned w = *(LAS unsigned*)(lds + (wave * 64 + cc) * 272 + lane * 4); const float a = bf_lo(w), b = bf_hi(w); s0 += a; q0 += a * a; s1 += b; q1 += b * b; }
                    ST[(wave * 64 + lane) * 4 + 0] = s0; ST[(wave * 64 + lane) * 4 + 1] = q0; ST[(wave * 64 + lane) * 4 + 2] = s1; ST[(wave * 64 + lane) * 4 + 3] = q1;
                    __syncthreads();
                    s0 = s1 = q0 = q1 = 0.f;
#pragma unroll
                    for (int o = 0; o < 8; ++o) { const f32x4 t = *(LAS f32x4*)(ST + (o * 64 + lane) * 4); s0 += t[0]; q0 += t[1]; s1 += t[2]; q1 += t[3]; }
                    const float m0 = s0 * (1.f / 512.f), m1 = s1 * (1.f / 512.f);
                    const float r0 = 1.f / sqrtf(fmaxf(q0 * (1.f / 512.f) - m0 * m0, 0.f) + LN_EPS), r1 = 1.f / sqrtf(fmaxf(q1 * (1.f / 512.f) - m1 * m1, 0.f) + LN_EPS);
                    const float gl = lng[wave * 64 + lane], bl = lnb[wave * 64 + lane];
#pragma unroll 8
                    for (int cc = 0; cc < 64; ++cc) { const int ch = wave * 64 + cc; LAS unsigned* pw = (LAS unsigned*)(lds + ch * 272 + lane * 4); const unsigned w = *pw;
                        const float gg = __builtin_bit_cast(float, __builtin_amdgcn_readlane(__builtin_bit_cast(int, gl), cc)), bb = __builtin_bit_cast(float, __builtin_amdgcn_readlane(__builtin_bit_cast(int, bl), cc));
                        *pw = cvt_pk_bf16((bf_lo(w) - m0) * r0 * gg + bb, (bf_hi(w) - m1) * r1 * gg + bb); }
                    __syncthreads();
                }
                {
                    const int fr = lane & 15, fq = lane >> 4, h = wave;
                    f32x4 acc[8][4];
#pragma unroll
                    for (int mt = 0; mt < 8; ++mt)
#pragma unroll
                        for (int nt = 0; nt < 4; ++nt) acc[mt][nt] = (f32x4){0.f, 0.f, 0.f, 0.f};
                    const bf16_t* Wh = Wl + (size_t)h * SBLK * SBLK;
                    bf16x8 afr[8];
#pragma unroll
                    for (int mt = 0; mt < 8; ++mt) afr[mt] = *(const bf16x8*)(Wh + (size_t)(mt * 16 + fr) * SBLK + fq * 8);
#pragma unroll 1
                    for (int ks = 0; ks < 4; ++ks) {
                        bf16x8 bfr[4], anx[8];
#pragma unroll
                        for (int nt = 0; nt < 4; ++nt) bfr[nt] = *(const LAS bf16x8*)(lds + (h * 64 + nt * 16 + fr) * 272 + (ks * 32 + fq * 8) * 2);
#pragma unroll
                        for (int mt = 0; mt < 8; ++mt) anx[mt] = *(const bf16x8*)(Wh + (size_t)(mt * 16 + fr) * SBLK + ((ks + 1) & 3) * 32 + fq * 8);
#pragma unroll
                        for (int mt = 0; mt < 8; ++mt)
#pragma unroll
                            for (int nt = 0; nt < 4; ++nt) acc[mt][nt] = __builtin_amdgcn_mfma_f32_16x16x32_bf16(bfr[nt], afr[mt], acc[mt][nt], 0, 0, 0);
#pragma unroll
                        for (int mt = 0; mt < 8; ++mt) afr[mt] = anx[mt];
                    }
                    float part[8];
#pragma unroll
                    for (int mt = 0; mt < 8; ++mt) { const int i = mt * 16 + fr; const float bias = bs[h * SBLK + i]; float q = 0.f;
#pragma unroll
                        for (int nt = 0; nt < 4; ++nt) { const u32x2 uu = *(const u32x2*)(US + (size_t)(tok0 + i) * DSGU + h * 64 + nt * 16 + fq * 4); f32x4 o = acc[mt][nt] + bias;
                            o[0] *= bf_lo(uu.x); o[1] *= bf_hi(uu.x); o[2] *= bf_lo(uu.y); o[3] *= bf_hi(uu.y); acc[mt][nt] = o; q += (o[0] * o[0] + o[1] * o[1]) + (o[2] * o[2] + o[3] * o[3]); }
                        q += __shfl_xor(q, 16); q += __shfl_xor(q, 32); part[mt] = q; if ((mt & 3) == 3) asm volatile("" ::: "memory"); }
                    if (fq == 0) {
#pragma unroll
                        for (int mt = 0; mt < 8; ++mt) ST[(mt * 16 + fr) * 8 + h] = part[mt]; }
                    __syncthreads();
#pragma unroll
                    for (int mt = 0; mt < 8; ++mt) { const int i = mt * 16 + fr; const f32x4 a = *(LAS f32x4*)(ST + i * 8), b = *(LAS f32x4*)(ST + i * 8 + 4);
                        const float rs = 1.f / sqrtf(((a[0] + a[1]) + (a[2] + a[3]) + (b[0] + b[1]) + (b[2] + b[3])) * (1.f / 512.f) + LN_EPS);
#pragma unroll
                        for (int nt = 0; nt < 4; ++nt) { const int ch = h * 64 + nt * 16 + fq * 4; const f32x4 gg = *(const f32x4*)(gsg + ch); const f32x4 o = acc[mt][nt] * rs * gg;
                            u32x2 w; w.x = cvt_pk_bf16(o[0], o[1]); w.y = cvt_pk_bf16(o[2], o[3]); *(u32x2*)(YMIX + (size_t)(tok0 + i) * DM + 512 + ch) = w; } asm volatile("" ::: "memory"); }
                    __syncthreads();
                }
            }
            for (int un = bx; un < NG * 4; un += G) { const int g = un >> 2, pm = un & 3;
                pg8::Gemm gm{UA + (size_t)g * NROW * UAP, PT + (size_t)g * 256 * 512, NROW, 256, 512, UAP, 512}; pg8::OneUnit S{{pm, 0}}; EpiSloc E{SLOC + (size_t)g * NROW * 128}; pg8::gemm_phase(lds, gm, S, E); }
        }
#endif
        PHASE_END
        PHASE_BEGIN
#if !defined(ONLY) || ONLY == 4
        for (int w = bx; w < BATCH * NG; w += G) {
            const int b = w / NG, g = w % NG, lg = l * NG + g, seg = wave;
            const float2 aT = ET[((size_t)lg * NP + lane) * (TC + 1) + TC];
            const float* sl = SLOC + ((size_t)g * NROW + b * NCH + seg * 16) * 128 + lane;
            bf16_t* ua = UA + ((size_t)g * NROW + b * NCH + seg * 16) * UAP + 512 + lane;
            float lr[16], li[16];
#pragma unroll
            for (int q = 0; q < 16; ++q) { lr[q] = sl[(size_t)q * 128]; li[q] = sl[(size_t)q * 128 + 64]; }
            float sr = 0.f, si = 0.f;
#pragma unroll
            for (int q = 0; q < 16; ++q) { const float tr = aT.x * sr - aT.y * si + lr[q]; si = aT.x * si + aT.y * sr + li[q]; sr = tr; }
            LAS float* EX = (LAS float*)lds;
            EX[(seg * 64 + lane) * 2] = sr; EX[(seg * 64 + lane) * 2 + 1] = si;
            float2 a16 = aT;
#pragma unroll
            for (int q = 0; q < 4; ++q) { const float tr = a16.x * a16.x - a16.y * a16.y; a16.y = 2.f * a16.x * a16.y; a16.x = tr; }
            __syncthreads();
            sr = 0.f; si = 0.f;
            for (int v = 0; v < seg; ++v) { const float ex = EX[(v * 64 + lane) * 2], ey = EX[(v * 64 + lane) * 2 + 1]; const float tr = a16.x * sr - a16.y * si + ex; si = a16.x * si + a16.y * sr + ey; sr = tr; }
#pragma unroll
            for (int q = 0; q < 16; ++q) { ua[(size_t)q * UAP] = (bf16_t)f2bf(sr); ua[(size_t)q * UAP + 64] = (bf16_t)f2bf(si);
                const float tr = aT.x * sr - aT.y * si + lr[q]; si = aT.x * si + aT.y * sr + li[q]; sr = tr; }
            __syncthreads();
        }
#endif
        PHASE_END
        PHASE_BEGIN
#if !defined(ONLY) || ONLY == 5
        for (int un = bx; un < NG * 8; un += G) { const int g = un >> 3, pm = (un & 7) >> 1, pn = un & 1;
            pg8::Gemm gm{UA + (size_t)g * NROW * UAP, KM + (size_t)g * 512 * UAP, NROW, 512, UAP, UAP, UAP}; pg8::OneUnit S{{pm, pn}}; EpiY E{YACT, g}; pg8::gemm_phase(lds, gm, S, E); }
#endif
        PHASE_END
        PHASE_BEGIN
#if !defined(ONLY) || ONLY == 6
        { pg8::Gemm g{YACT, WGLU + (size_t)l * DSSM * DSSM, MTOK, DSSM, DSSM, DSSM, DSSM}; pg8::StaticOrder S; S.init(MTOK, DSSM, G, bx); EpiGlu E{YACT, YMIX, SSQB}; pg8::gemm_phase(lds, g, S, E); }
#endif
        PHASE_END
        PHASE_BEGIN
#if !defined(ONLY) || ONLY == 8
        { pg8::Gemm g{YMIX, WOUT + (size_t)l * DM * DM, MTOK, DM, DM, DM, DM}; pg8::StaticOrder S; S.init(MTOK, DM, G, bx);
          EpiRes<false, false> E{H, nullptr, nullptr, STB + (size_t)(2 * l) * MTOK * 2, l ? in[29] + (l - 1) * DM : in[2], l ? in[30] + (l - 1) * DM : in[3], (i64*)(STB + (size_t)(2 * l + 1) * MTOK * 2), SSQB}; pg8::gemm_phase(lds, g, S, E); }
#endif
        PHASE_END
        PHASE_BEGIN
#if !defined(ONLY) || ONLY == 10
        for (size_t i = gt; i < (size_t)MTOK; i += NGT) SSQB[i] = 0;
        { int lp_ = lane; asm volatile("" : "+v"(lp_));
        for (int m0 = gw; m0 < MTOK; m0 += 2 * NGW) { f32x4 pv[2];
#pragma unroll
            for (int j = 0; j < 2; ++j) { const int m = m0 + j * NGW; if (m < MTOK) pv[j] = __builtin_nontemporal_load((const f32x4*)(in[1] + ((size_t)l * MTOK + m) * PLE) + lp_); }
#pragma unroll
            for (int j = 0; j < 2; ++j) { const int m = m0 + j * NGW; if (m < MTOK) { u32x2 w; w.x = cvt_pk_bf16(pv[j][0], pv[j][1]); w.y = cvt_pk_bf16(pv[j][2], pv[j][3]); __builtin_nontemporal_store(w, (u32x2*)(GB + (size_t)m * GPP) + lp_); } } } asm volatile("" ::: "memory"); }
        { pg8::Gemm g{H, WPG + (size_t)l * DM * DM, MTOK, DM, DM, DM, DM}; pg8::StaticOrder S; S.init(MTOK, DM, G, bx); EpiGate E{GT, in[28] + l * DM, STB + (size_t)(2 * l + 1) * MTOK * 2, CSV + l * CS_L + CSO_PG, CSV + l * CS_L + BWO_PG}; pg8::gemm_phase(lds, g, S, E); }
        { pg8::Gemm g{H, WGU + (size_t)l * 2 * DFF * DM, MTOK, 2 * DFF, DM, DM, DM}; pg8::StaticOrder S; S.init(MTOK, 2 * DFF, G, bx); EpiGU E{GB, STB + (size_t)(2 * l + 1) * MTOK * 2, CSV + l * CS_L + CSO_GU, CSV + l * CS_L + BWO_GU}; pg8::gemm_phase(lds, g, S, E);
        }
#endif
        PHASE_END
        PHASE_BEGIN
#if !defined(ONLY) || ONLY == 11
        { pg8::Gemm g{GB, WD + (size_t)l * DM * GPP, MTOK, DM, GPP, GPP, GPP}; pg8::StaticOrder S; S.init(MTOK, DM, G, bx);
          EpiRes<true, false> E{H, GT, nullptr, STB + (size_t)(2 * l + 1) * MTOK * 2, in[21] + l * DM, in[22] + l * DM, (i64*)(STB + (size_t)(2 * l + 2) * MTOK * 2), nullptr}; pg8::gemm_phase(lds, g, S, E); }
#endif
        PHASE_END
    }
    PHASE_BEGIN
#if !defined(ONLY) || ONLY == 12
    {
        const i64* STL = STB + (size_t)(2 * DEPTH) * MTOK * 2; const float* g2 = in[29] + (DEPTH - 1) * DM; const float* b2 = in[30] + (DEPTH - 1) * DM;
        for (int m = gw; m < MTOK; m += NGW) { const RowStat rs = row_stat(STL, m);
#pragma unroll
            for (int j = 0; j < 4; ++j) { const u32x2 hh = ((const u32x2*)(H + (size_t)m * DM))[lane + 64 * j]; const f32x4 gg = ((const f32x4*)g2)[lane + 64 * j], bb = ((const f32x4*)b2)[lane + 64 * j];
                f32x4 o = {bf_lo(hh.x), bf_hi(hh.x), bf_lo(hh.y), bf_hi(hh.y)}; o = (o - rs.mu) * rs.rs * gg + bb; __builtin_nontemporal_store(o, (f32x4*)(X + (size_t)m * DM) + lane + 64 * j); } }
    }
#endif
    PHASE_END
#ifdef EXTRA_SYNCS
    if (hi - lo > 1) for (int i = 0; i < EXTRA_SYNCS; ++i) grid.sync();
#endif
#undef PHASE_BEGIN
#undef PHASE_END
}

constexpr int N_PHASES = 2 + 8 * DEPTH + 1;

extern "C" void kernel_launch(void* const* d_in, const int* in_sizes, int n_in, void* d_out, int out_size, void* d_ws, size_t ws_size, hipStream_t stream) {
    static int grid = 0;
    if (grid == 0) {
        if (n_in != 31 || out_size != MTOK * DM || ws_size < WS_END) { fprintf(stderr, "kernel_launch: unexpected shapes (n_in %d out %d ws %zu)\n", n_in, out_size, ws_size); grid = -1; return; }
        int dev = 0, cus = 0, per_cu = 0;
        hipGetDevice(&dev); hipDeviceGetAttribute(&cus, hipDeviceAttributeMultiprocessorCount, dev);
        if (hipFuncSetAttribute((const void*)mega_fwd, hipFuncAttributeMaxDynamicSharedMemorySize, LDS_BYTES) != hipSuccess) { fprintf(stderr, "kernel_launch: hipFuncSetAttribute failed\n"); }
        if (hipOccupancyMaxActiveBlocksPerMultiprocessor(&per_cu, (const void*)mega_fwd, NTHR, LDS_BYTES) != hipSuccess || per_cu < 1) { fprintf(stderr, "kernel_launch: occupancy query says %d\n", per_cu); per_cu = 1; }
        (void)hipGetLastError();
        grid = cus * per_cu;
    }
    if (grid < 0) return;
    if (hipMemsetAsync((unsigned char*)d_ws + WS_CTL, 0, CTL_BYTES, stream) != hipSuccess) fprintf(stderr, "kernel_launch: memset failed\n");
    Args a{};
    for (int i = 0; i < 31; ++i) a.in[i] = (const float*)d_in[i];
    a.out = (float*)d_out; a.ws = (unsigned char*)d_ws;
#if MK_SPLIT
    for (int p = 0; p < N_PHASES; ++p) { a.lo = p; a.hi = p + 1; hipLaunchKernelGGL(mega_fwd, dim3(grid), dim3(NTHR), LDS_BYTES, stream, a); }
#else
    a.lo = 0; a.hi = N_PHASES;
    void* kargs[] = {&a};
    hipError_t e = hipLaunchCooperativeKernel((const void*)mega_fwd, dim3(grid), dim3(NTHR), kargs, LDS_BYTES, stream);
    if (e != hipSuccess) fprintf(stderr, "kernel_launch: cooperative launch failed: %s (grid %d)\n", hipGetErrorString(e), grid);
#endif
}
```
